# Optimizing an MI355X kernel written in HIP

```python
import math
import jax
import jax.numpy as jnp
from jax import lax
import numpy as np

D_MODEL = 2048
BATCH = 2
SEQ = 16384
DEPTH = 2

GRID_W = 64
CTX_LEN = 256
EPS = 1e-6
POOL_W = 512
POOL_GROUPS = 4
POOL_GROUP_W = POOL_W // POOL_GROUPS
POOL_WINDOWS = (2, 4, 8, 16)
N_HEADS = 8
Q_LORA = 512
KV_LORA = 256
QK_NOPE = 128
QK_ROPE = 64
QK_HEAD = QK_NOPE + QK_ROPE
V_HEAD = 128
ROPE_FREQS = QK_ROPE // 4
ROPE_THETA = 10000.0
SOFTMAX_SCALE = QK_HEAD ** -0.5
Q_BLOCK = 128
SG_W = 512
SG_GROUPS = 4
SG_GROUP_W = SG_W // SG_GROUPS
CHUNK = 128
N_BRANCH = 3
D_FF = 5632
CONV_W = 3
IN_SPLITS = (POOL_W, POOL_W + Q_LORA, POOL_W + Q_LORA + KV_LORA, POOL_W + Q_LORA + KV_LORA + QK_ROPE, POOL_W + Q_LORA + KV_LORA + QK_ROPE + 2 * SG_W)
IN_COLS = IN_SPLITS[-1] + N_BRANCH * D_MODEL

kernel_name = 'hybrid_pool_mla_sgmlp_convffn_dit'


def rmsnorm(x, g):
    x32 = x.astype(jnp.float32)
    y = x32 * lax.rsqrt(jnp.mean(x32 * x32, axis=-1, keepdims=True) + EPS)
    return (y * g.astype(jnp.float32)).astype(x.dtype)


def layernorm_gain(x, g):
    x32 = x.astype(jnp.float32)
    xc = x32 - jnp.mean(x32, axis=-1, keepdims=True)
    y = xc * lax.rsqrt(jnp.mean(xc * xc, axis=-1, keepdims=True) + EPS)
    return (y * g.astype(jnp.float32)).astype(x.dtype)


def modulate(h, shift, scale):
    return h * (1.0 + scale) + shift


def ada_modulation(s, ada_w, ada_b):
    m = s @ ada_w + ada_b
    return jnp.split(m[:, None, :], 6, axis=-1)


def axial_rope_tables(n_tokens):
    rows = n_tokens // GRID_W
    row = jnp.repeat(jnp.arange(rows, dtype=jnp.float32), GRID_W)
    col = jnp.tile(jnp.arange(GRID_W, dtype=jnp.float32), rows)
    inv_freq = ROPE_THETA ** (-jnp.arange(ROPE_FREQS, dtype=jnp.float32) / ROPE_FREQS)
    ang = jnp.stack([row[:, None] * inv_freq, col[:, None] * inv_freq], axis=1)
    return jnp.cos(ang)[:, None], jnp.sin(ang)[:, None]


def apply_axial_rope(x, cos, sin):
    xr = x.astype(jnp.float32).reshape(x.shape[:-1] + (2, 2, ROPE_FREQS))
    x1, x2 = xr[..., 0, :], xr[..., 1, :]
    out = jnp.stack([x1 * cos - x2 * sin, x2 * cos + x1 * sin], axis=-2)
    return out.reshape(x.shape).astype(x.dtype)


def pool_mix(z, pool_w, pool_scale):
    B, L, _ = z.shape
    cs = jnp.concatenate([jnp.zeros((B, 1, POOL_W), jnp.float32), jnp.cumsum(z.astype(jnp.float32), axis=1)], axis=1)
    t = jnp.arange(L)
    means = []
    for g, w in enumerate(POOL_WINDOWS):
        lo = jnp.clip(t - w // 2, 0, L)
        hi = jnp.clip(t + w // 2, 0, L)
        cg = cs[..., g * POOL_GROUP_W:(g + 1) * POOL_GROUP_W]
        cnt = (hi - lo).astype(jnp.float32)[None, :, None]
        means.append((jnp.take(cg, hi, axis=1) - jnp.take(cg, lo, axis=1)) / cnt)
    pooled = jnp.concatenate(means, axis=-1).astype(z.dtype) - z
    y = jnp.einsum('blgc,gcd->blgd', pooled.reshape(B, L, POOL_GROUPS, POOL_GROUP_W), pool_w)
    return y.reshape(B, L, POOL_W) * pool_scale


def spatial_gating(z, sg_norm_g, sg_w, sg_b):
    B, L, _ = z.shape
    u, v = jnp.split(jax.nn.gelu(z), 2, axis=-1)
    v = layernorm_gain(v, sg_norm_g).reshape(B, L // CHUNK, CHUNK, SG_GROUPS, SG_GROUP_W)
    s = jnp.einsum('gpq,bnqgc->bnpgc', sg_w, v) + sg_b.T[None, None, :, :, None]
    return u * s.reshape(B, L, SG_W)


def mla_queries(z_q, p, rope):
    B, L, _ = z_q.shape
    q = (rmsnorm(z_q, p['q_lat_g']) @ p['w_uq']).reshape(B, L, N_HEADS, QK_HEAD)
    q = rmsnorm(q, p['q_norm_g'])
    if rope is not None:
        q = jnp.concatenate([q[..., :QK_NOPE], apply_axial_rope(q[..., QK_NOPE:], *rope)], axis=-1)
    return q


def mla_keys_values(z_kv, z_kr, p, rope):
    B, L, _ = z_kv.shape
    kv = (rmsnorm(z_kv, p['kv_lat_g']) @ p['w_ukv']).reshape(B, L, N_HEADS, QK_NOPE + V_HEAD)
    k_nope, v = kv[..., :QK_NOPE], kv[..., QK_NOPE:]
    k_rope = jnp.broadcast_to(z_kr[:, :, None, :], (B, L, N_HEADS, QK_ROPE))
    k = rmsnorm(jnp.concatenate([k_nope, k_rope], axis=-1), p['k_norm_g'])
    if rope is not None:
        k = jnp.concatenate([k[..., :QK_NOPE], apply_axial_rope(k[..., QK_NOPE:], *rope)], axis=-1)
    return k, v


def attend_latent(q, k, v):
    B, L, H, Dq = q.shape
    qb = q.reshape(B, L // Q_BLOCK, Q_BLOCK, H, Dq).transpose(1, 0, 2, 3, 4)

    def block(qi):
        s = jnp.einsum('bqhd,bkhd->bhqk', qi, k, preferred_element_type=jnp.float32) * SOFTMAX_SCALE
        pr = jax.nn.softmax(s, axis=-1).astype(v.dtype)
        return jnp.einsum('bhqk,bkhd->bqhd', pr, v)

    o = lax.map(block, qb)
    return o.transpose(1, 0, 2, 3, 4).reshape(B, L, H * V_HEAD)


def attend_context(q, k, v):
    B, C, H, _ = q.shape
    s = jnp.einsum('bqhd,bkhd->bhqk', q, k, preferred_element_type=jnp.float32) * SOFTMAX_SCALE
    pr = jax.nn.softmax(s, axis=-1).astype(v.dtype)
    return jnp.einsum('bhqk,bkhd->bqhd', pr, v).reshape(B, C, H * V_HEAD)


def conv_ffn(h, p):
    L = h.shape[1]
    u = h @ p['ffn_up']
    pad = CONV_W // 2
    up = jnp.pad(u, ((0, 0), (pad, pad), (0, 0)))
    w = p['ffn_conv_w']
    acc = p['ffn_conv_b'] + up[:, 0:L] * w[0]
    for j in range(1, CONV_W):
        acc = acc + up[:, j:j + L] * w[j]
    a, val = jnp.split(acc, 2, axis=-1)
    return (jax.nn.silu(a) * val) @ p['ffn_down']


def merge_branches(z, attn, p):
    z_pool, z_sg, z_gate = z[0], z[4], z[5]
    pool_out = pool_mix(z_pool, p['pool_w'], p['pool_scale'])
    sg_out = spatial_gating(z_sg, p['sg_norm_g'], p['sg_w'], p['sg_b'])
    g_pool, g_mla, g_sg = jnp.split(jax.nn.sigmoid(z_gate), N_BRANCH, axis=-1)
    y = g_pool * (pool_out @ p['w_br_pool']) + g_mla * (attn @ p['w_br_mla']) + g_sg * (sg_out @ p['w_br_sg'])
    return y @ p['w_o']


def hybrid_layer(xl, xc, s_lat, s_ctx, rope, p, ctx_out):
    sh1, sc1, g1, sh2, sc2, g2 = ada_modulation(s_lat, p['ada_w'], p['ada_b'])
    csh1, csc1, cg1, csh2, csc2, cg2 = ada_modulation(s_ctx, p['ada_w'], p['ada_b'])
    hl = modulate(rmsnorm(xl, p['norm1_g']), sh1, sc1)
    hc = modulate(rmsnorm(xc, p['norm1_g']), csh1, csc1)
    zl = jnp.split(hl @ p['w_in'], IN_SPLITS, axis=-1)
    zc = jnp.split(hc @ p['w_in'], IN_SPLITS, axis=-1)
    kc, vc = mla_keys_values(zc[2], zc[3], p, None)
    kl, vl = mla_keys_values(zl[2], zl[3], p, rope)
    ql = mla_queries(zl[1], p, rope)
    attn_l = attend_latent(ql, jnp.concatenate([kl, kc], axis=1), jnp.concatenate([vl, vc], axis=1))
    xl = xl + g1 * merge_branches(zl, attn_l, p)
    xl = xl + g2 * conv_ffn(modulate(rmsnorm(xl, p['norm2_g']), sh2, sc2), p)
    if ctx_out:
        qc = mla_queries(zc[1], p, None)
        attn_c = attend_context(qc, kc, vc)
        xc = xc + cg1 * merge_branches(zc, attn_c, p)
        xc = xc + cg2 * conv_ffn(modulate(rmsnorm(xc, p['norm2_g']), csh2, csc2), p)
    return xl, xc


def setup_inputs(seed: int = 0) -> dict:
    key = jax.random.key(seed)
    ks = jax.random.split(key, 32)
    f32 = jnp.float32

    def nrm(k, shape, scale=1.0):
        return jax.random.normal(k, shape, f32) * scale

    def gain(k, shape, centre=1.0):
        return centre + 0.1 * jax.random.normal(k, shape, f32)

    F2 = 2 * D_FF
    return {
        'x': nrm(ks[0], (BATCH, SEQ, D_MODEL)),
        'c': nrm(ks[1], (BATCH, D_MODEL)),
        'ctx': nrm(ks[2], (BATCH, CTX_LEN, D_MODEL)),
        'c_ctx': nrm(ks[3], (D_MODEL,)),
        'ada_w': nrm(ks[4], (DEPTH, D_MODEL, 6 * D_MODEL), 0.5 * D_MODEL ** -0.5),
        'ada_b': nrm(ks[5], (DEPTH, 6 * D_MODEL), 0.01),
        'norm1_g': gain(ks[6], (DEPTH, D_MODEL)),
        'w_in': nrm(ks[7], (DEPTH, D_MODEL, IN_COLS), D_MODEL ** -0.5),
        'pool_w': nrm(ks[8], (DEPTH, POOL_GROUPS, POOL_GROUP_W, POOL_GROUP_W), POOL_GROUP_W ** -0.5),
        'pool_scale': gain(ks[9], (DEPTH, POOL_W)),
        'q_lat_g': gain(ks[10], (DEPTH, Q_LORA)),
        'w_uq': nrm(ks[11], (DEPTH, Q_LORA, N_HEADS * QK_HEAD), Q_LORA ** -0.5),
        'kv_lat_g': gain(ks[12], (DEPTH, KV_LORA)),
        'w_ukv': nrm(ks[13], (DEPTH, KV_LORA, N_HEADS * (QK_NOPE + V_HEAD)), KV_LORA ** -0.5),
        'q_norm_g': gain(ks[14], (DEPTH, QK_HEAD), 1.5),
        'k_norm_g': gain(ks[15], (DEPTH, QK_HEAD), 1.5),
        'sg_norm_g': gain(ks[16], (DEPTH, SG_W)),
        'sg_w': nrm(ks[17], (DEPTH, SG_GROUPS, CHUNK, CHUNK), CHUNK ** -0.5),
        'sg_b': gain(ks[18], (DEPTH, SG_GROUPS, CHUNK)),
        'w_br_pool': nrm(ks[19], (DEPTH, POOL_W, D_MODEL), POOL_W ** -0.5),
        'w_br_mla': nrm(ks[20], (DEPTH, N_HEADS * V_HEAD, D_MODEL), (N_HEADS * V_HEAD) ** -0.5),
        'w_br_sg': nrm(ks[21], (DEPTH, SG_W, D_MODEL), SG_W ** -0.5),
        'w_o': nrm(ks[22], (DEPTH, D_MODEL, D_MODEL), D_MODEL ** -0.5),
        'norm2_g': gain(ks[23], (DEPTH, D_MODEL)),
        'ffn_up': nrm(ks[24], (DEPTH, D_MODEL, F2), D_MODEL ** -0.5),
        'ffn_conv_w': nrm(ks[25], (DEPTH, CONV_W, F2), 0.3).at[:, CONV_W // 2].add(1.0),
        'ffn_conv_b': nrm(ks[26], (DEPTH, F2), 0.01),
        'ffn_down': nrm(ks[27], (DEPTH, D_FF, D_MODEL), D_FF ** -0.5),
    }


def reference(x, c, ctx, c_ctx, ada_w, ada_b, norm1_g, w_in, pool_w, pool_scale, q_lat_g, w_uq, kv_lat_g, w_ukv, q_norm_g, k_norm_g, sg_norm_g, sg_w, sg_b, w_br_pool, w_br_mla, w_br_sg, w_o, norm2_g, ffn_up, ffn_conv_w, ffn_conv_b, ffn_down):
    s_lat = jax.nn.silu(c)
    s_ctx = jax.nn.silu(c_ctx)[None, :]
    rope = axial_rope_tables(x.shape[1])
    xl, xc = x, ctx
    for i in range(DEPTH):
        p = {
            'ada_w': ada_w[i], 'ada_b': ada_b[i], 'norm1_g': norm1_g[i], 'w_in': w_in[i],
            'pool_w': pool_w[i], 'pool_scale': pool_scale[i],
            'q_lat_g': q_lat_g[i], 'w_uq': w_uq[i], 'kv_lat_g': kv_lat_g[i], 'w_ukv': w_ukv[i],
            'q_norm_g': q_norm_g[i], 'k_norm_g': k_norm_g[i],
            'sg_norm_g': sg_norm_g[i], 'sg_w': sg_w[i], 'sg_b': sg_b[i],
            'w_br_pool': w_br_pool[i], 'w_br_mla': w_br_mla[i], 'w_br_sg': w_br_sg[i], 'w_o': w_o[i],
            'norm2_g': norm2_g[i], 'ffn_up': ffn_up[i], 'ffn_conv_w': ffn_conv_w[i],
            'ffn_conv_b': ffn_conv_b[i], 'ffn_down': ffn_down[i],
        }
        xl, xc = hybrid_layer(xl, xc, s_lat, s_ctx, rope, p, i < DEPTH - 1)
    return xl
```

```cpp
#include <hip/hip_runtime.h>
#include <hip/hip_cooperative_groups.h>
#include <cstdio>
#include <cstdint>
namespace cg = cooperative_groups;

typedef unsigned short bf16_t;
typedef short bf16x8 __attribute__((ext_vector_type(8)));
typedef short s16x4 __attribute__((ext_vector_type(4)));
typedef float f32x4 __attribute__((ext_vector_type(4)));
typedef float f32x16 __attribute__((ext_vector_type(16)));
typedef unsigned u32x4 __attribute__((ext_vector_type(4)));
typedef unsigned u32x2 __attribute__((ext_vector_type(2)));
#define LAS __attribute__((address_space(3)))

constexpr int D = 2048, NB = 2, SEQ = 16384, CTX = 256, NLAT = NB * SEQ, NCTX = NB * CTX, MT = NLAT + NCTX;
constexpr int INC = 8512, F2 = 11264, DFF = 5632, KVS = SEQ + CTX;
constexpr int NTHR = 512;
constexpr float EPS = 1e-6f;
constexpr int HROWS = 33600;
constexpr int HP_LAT = SEQ + 2, HP_CTX0 = 2 * HP_LAT, HP_CTX = CTX + 2;

constexpr size_t al256(size_t x) { return (x + 255) & ~(size_t)255; }
constexpr size_t OFF_CTL = 0;
constexpr size_t OFF_MOD = 4096;
constexpr size_t OFF_XC = al256(OFF_MOD + 2 * 3 * 12288 * 4);
constexpr size_t OFF_WB = al256(OFF_XC + (size_t)NCTX * D * 4);
constexpr size_t W_SM = 0;
constexpr size_t W_G = W_SM + (size_t)2560 * 2048;
constexpr size_t W_UQ = W_G + (size_t)6144 * 2048;
constexpr size_t W_UKV = W_UQ + (size_t)1536 * 512;
constexpr size_t W_POOL = W_UKV + (size_t)2048 * 256;
constexpr size_t W_SG = W_POOL + 65536;
constexpr size_t W_BP = W_SG + 65536;
constexpr size_t W_BM = W_BP + (size_t)2048 * 512;
constexpr size_t W_BS = W_BM + (size_t)2048 * 1024;
constexpr size_t W_O = W_BS + (size_t)2048 * 512;
constexpr size_t W_UP = W_O + (size_t)2048 * 2048;
constexpr size_t W_DN = W_UP + (size_t)F2 * 2048;
constexpr size_t W_END = W_DN + (size_t)2048 * DFF;
constexpr size_t OFF_H = al256(OFF_WB + W_END * 2);
constexpr size_t OFF_GS = al256(OFF_H + (size_t)HROWS * D * 2);
constexpr size_t OFF_YS = al256(OFF_GS + (size_t)256 * 131072);
constexpr size_t OFF_ACT = al256(OFF_YS + (size_t)256 * 262144);
constexpr size_t A_ZPOOL = 0;
constexpr size_t A_POOLED = A_ZPOOL + (size_t)MT * 512;
constexpr size_t A_ZQ = A_POOLED + (size_t)MT * 512;
constexpr size_t A_ZKV = A_ZQ + (size_t)MT * 512;
constexpr size_t A_ZKR = A_ZKV + (size_t)MT * 256;
constexpr size_t A_U = A_ZKR + (size_t)MT * 64;
constexpr size_t A_VG = A_U + (size_t)MT * 512;
constexpr size_t A_Q = A_VG + (size_t)MT * 512;
constexpr size_t A_K = A_Q + (size_t)MT * 1536;
constexpr size_t A_V = A_K + (size_t)MT * 1536;
constexpr size_t A_ATT = A_V + (size_t)MT * 1024;
constexpr size_t A_END = A_ATT + (size_t)MT * 1024;
constexpr size_t A_Y = A_END;
constexpr size_t A_F = 0;
static_assert((size_t)MT * DFF <= A_END, "f fits");
constexpr size_t WS_NEED = OFF_ACT + (A_END + (size_t)MT * 2048) * 2;
static_assert(WS_NEED <= ((size_t)1 << 30), "workspace plan must fit 1 GiB");

constexpr int LDS_BYTES = 139264;

struct P {
  const float *x, *c, *ctx, *c_ctx, *ada_w, *ada_b, *norm1_g, *w_in, *pool_w, *pool_scale, *q_lat_g, *w_uq, *kv_lat_g, *w_ukv, *q_norm_g, *k_norm_g,
      *sg_norm_g, *sg_w, *sg_b, *w_br_pool, *w_br_mla, *w_br_sg, *w_o, *norm2_g, *ffn_up, *ffn_conv_w, *ffn_conv_b, *ffn_down;
  float* out; unsigned char* ws;
};

typedef __bf16 bf16v2 __attribute__((ext_vector_type(2)));
typedef float f32x2 __attribute__((ext_vector_type(2)));
__device__ __forceinline__ unsigned cvtpk(float lo, float hi) { f32x2 v = {lo, hi}; bf16v2 b = __builtin_convertvector(v, bf16v2); return __builtin_bit_cast(unsigned, b); }
__device__ __forceinline__ float bflo(unsigned u) { return __uint_as_float(u << 16); }
__device__ __forceinline__ float bfhi(unsigned u) { return __uint_as_float(u & 0xffff0000u); }
__device__ __forceinline__ float wave_sum(float v) {
#pragma unroll
  for (int o = 32; o > 0; o >>= 1) v += __shfl_xor(v, o);
  return v;
}
__device__ __forceinline__ int otid() { int t = threadIdx.x; asm volatile("" : "+v"(t)); return t; }
__device__ __forceinline__ int obid() { int t = blockIdx.x; asm volatile("" : "+s"(t)); return t; }
__device__ __forceinline__ int ogrid() { int t = gridDim.x; asm volatile("" : "+s"(t)); return t; }
__device__ __forceinline__ float sigmoidf_(float x) { return __builtin_amdgcn_rcpf(1.f + __expf(-x)); }
__device__ __forceinline__ float gelu_tanh(float x) { const float u = 1.5957691216057308f * (x + 0.044715f * x * x * x); return x * __builtin_amdgcn_rcpf(1.f + __expf(-u)); }
__device__ __forceinline__ void unpack8(u32x4 w, float* f) {
  f[0] = bflo(w.x); f[1] = bfhi(w.x); f[2] = bflo(w.y); f[3] = bfhi(w.y); f[4] = bflo(w.z); f[5] = bfhi(w.z); f[6] = bflo(w.w); f[7] = bfhi(w.w);
}
__device__ __forceinline__ u32x4 pack8(const float* f) { u32x4 w; w.x = cvtpk(f[0], f[1]); w.y = cvtpk(f[2], f[3]); w.z = cvtpk(f[4], f[5]); w.w = cvtpk(f[6], f[7]); return w; }

__device__ __forceinline__ void grid_barrier(unsigned* ctr, unsigned target) {
  asm volatile("s_waitcnt vmcnt(0) lgkmcnt(0)" ::: "memory");
  __syncthreads();
  if (threadIdx.x == 0) {
    __builtin_amdgcn_fence(__ATOMIC_RELEASE, "agent");
    asm volatile("s_waitcnt vmcnt(0)" ::: "memory");
    __hip_atomic_fetch_add(ctr, 1u, __ATOMIC_RELAXED, __HIP_MEMORY_SCOPE_AGENT);
    while (__hip_atomic_load(ctr, __ATOMIC_RELAXED, __HIP_MEMORY_SCOPE_AGENT) < target) __builtin_amdgcn_s_sleep(2);
    __builtin_amdgcn_fence(__ATOMIC_ACQUIRE, "agent");
    asm volatile("s_waitcnt vmcnt(0)" ::: "memory");
  }
  __syncthreads();
}

__device__ __forceinline__ int kv_row(int r) { return r < NLAT ? (r >> 14) * KVS + (r & (SEQ - 1)) : ((r - NLAT) >> 8) * KVS + SEQ + ((r - NLAT) & 255); }
__device__ __forceinline__ int mod_row(int r) { return r < NLAT ? (r >> 14) : 2; }

__device__ __forceinline__ void tile_order(int L, int nM, int nN, int& pm, int& pn) {
  const int nwg = nM * nN; int wgid = L;
  { const int q = nwg / 8, r = nwg % 8, xcd = wgid % 8, off = wgid / 8; wgid = (xcd < r ? xcd * (q + 1) : r * (q + 1) + (xcd - r) * q) + off; }
  const int nig = 2 * nN, gid = wgid / nig, fm = gid * 2, gsz = (nM - fm) < 2 ? (nM - fm) : 2;
  pm = fm + ((wgid % nig) % gsz); pn = (wgid % nig) / gsz;
}

__device__ __forceinline__ int lds_byte(int r, int c) { int st = (r >> 4) * 2 + (c >> 5), rr = r & 15, cc = c & 31, ob = rr * 64 + cc * 2; return st * 1024 + (ob ^ (((ob >> 9) & 1) << 5)); }
__device__ __forceinline__ void stage_rc(int b, int& R, int& C) { int st = b / 1024, sb = b % 1024, swz = sb ^ (((sb >> 9) & 1) << 5); R = (st >> 1) * 16 + swz / 64; C = (st & 1) * 32 + (swz % 64) / 2; }
#define GL_LDS(gp, lp) __builtin_amdgcn_global_load_lds((const __attribute__((address_space(1))) unsigned*)(gp), (__attribute__((address_space(3))) unsigned*)(lp), 16, 0, 0)

typedef f32x4 Acc[2][2][4][2];
#define QON(ai_, bj_) (!PART || ((qm >> ((ai_) * 2 + (bj_))) & 1))
template <bool ZERO, bool PART, class Epi>
__device__ __forceinline__ void gemm_tile_acc(const bf16_t* A, unsigned lda, const bf16_t* Bt, unsigned ldb, int K, LAS unsigned char* lds, Acc& acc, const Epi& epi, int qm = 15) {
  int tid = threadIdx.x; asm volatile("" : "+v"(tid));
  const int wid = __builtin_amdgcn_readfirstlane(tid >> 6), lane = tid & 63, wr = wid >> 2, wc = wid & 3, fr = lane & 15, fq = lane >> 4;
  unsigned voffA[2], voffB[2];
#pragma unroll
  for (int i = 0; i < 2; ++i) { int R, C; stage_rc(tid * 16 + i * 8192, R, C); voffA[i] = (unsigned)(R * lda + C) * 2u; voffB[i] = (unsigned)(R * ldb + C) * 2u; }
  const unsigned ldsw = (unsigned)wid * 1024u;
  const int aoff = lds_byte(wr * 64 + fr, fq * 8), boff = lds_byte(wc * 32 + fr, fq * 8);
  const char* cA = (const char*)A; const char* cB = (const char*)Bt;
  const size_t hA = (size_t)128 * lda * 2, hB = (size_t)128 * ldb * 2;
#define SAo(b, h) (((b) * 2 + (h)) * 16384)
#define SBo(b, h) ((4 + (b) * 2 + (h)) * 16384)
#define STG(bufoff, gbase, voff) do { _Pragma("unroll") for (int _i = 0; _i < 2; ++_i) \
    __builtin_amdgcn_global_load_lds((const unsigned*)((const char*)(gbase) + (voff)[_i]), (LAS unsigned*)(lds + (bufoff) + ldsw + _i * 8192), 16, 0, 0); } while (0)
#define STA(b, h, kt) STG(SAo(b, h), cA + (h) * hA + (size_t)(kt) * 128, voffA)
#define STB(b, h, kt) STG(SBo(b, h), cB + (h) * hB + (size_t)(kt) * 128, voffB)
#define LDA(dst, b, h) do { _Pragma("unroll") for (int m = 0; m < 4; ++m) _Pragma("unroll") for (int k = 0; k < 2; ++k) dst[m][k] = *(const LAS bf16x8*)(lds + SAo(b, h) + aoff + m * 2048 + k * 1024); } while (0)
#define LDB(dst, b, h) do { _Pragma("unroll") for (int n = 0; n < 2; ++n) _Pragma("unroll") for (int k = 0; k < 2; ++k) dst[n][k] = *(const LAS bf16x8*)(lds + SBo(b, h) + boff + n * 2048 + k * 1024); } while (0)
#define MMA(ai, bj, At_, Bt_) do { __builtin_amdgcn_s_setprio(1); \
    _Pragma("unroll") for (int m = 0; m < 4; ++m) _Pragma("unroll") for (int n = 0; n < 2; ++n) _Pragma("unroll") for (int k = 0; k < 2; ++k) \
      acc[ai][bj][m][n] = __builtin_amdgcn_mfma_f32_16x16x32_bf16(Bt_[n][k], At_[m][k], acc[ai][bj][m][n], 0, 0, 0); \
    __builtin_amdgcn_s_setprio(0); } while (0)
#define WAIT_V(n) asm volatile("s_waitcnt vmcnt(" #n ")" ::: "memory")
#define WAIT_L(n) asm volatile("s_waitcnt lgkmcnt(" #n ")" ::: "memory")
#define BAR __builtin_amdgcn_s_barrier()
#define SCHED __builtin_amdgcn_sched_barrier(0)
  if (ZERO) {
  float z0 = 0.f; asm volatile("" : "+v"(z0));
#pragma unroll
  for (int a = 0; a < 2; ++a)
#pragma unroll
    for (int b = 0; b < 2; ++b)
#pragma unroll
      for (int m = 0; m < 4; ++m)
#pragma unroll
        for (int n = 0; n < 2; ++n) acc[a][b][m][n] = (f32x4){z0, z0, z0, z0};
  }
#define MMQ(ai, bj, At_, Bt_) do { if (!PART || ((qm >> ((ai) * 2 + (bj))) & 1)) MMA(ai, bj, At_, Bt_); } while (0)
  bf16x8 At[4][2], B0[2][2], B1[2][2];
  const int nt = K / 64;
  STB(0, 0, 0); STA(0, 0, 0); STB(0, 1, 0); STA(0, 1, 0);
  if (wr == 1) BAR;
  WAIT_V(4); BAR;
  STB(1, 0, 1); STA(1, 0, 1); STB(1, 1, 1);
  WAIT_V(6); BAR;
  for (int t = 0; t < nt - 2; t += 2) {
    LDB(B0, 0, 0); SCHED; LDA(At, 0, 0); STA(1, 1, t + 1);
    WAIT_L(8); BAR; WAIT_L(0); MMQ(0, 0, At, B0); BAR; SCHED;
    LDB(B1, 0, 1); STB(0, 0, t + 2);
    BAR; WAIT_L(0); MMQ(0, 1, At, B1); BAR;
    LDA(At, 0, 1); STA(0, 0, t + 2);
    BAR; WAIT_L(0); MMQ(1, 0, At, B0); BAR; SCHED;
    STB(0, 1, t + 2);
    WAIT_V(6); BAR; MMQ(1, 1, At, B1); BAR;
    LDB(B0, 1, 0); SCHED; LDA(At, 1, 0); STA(0, 1, t + 2);
    WAIT_L(8); BAR; WAIT_L(0); MMQ(0, 0, At, B0); BAR; SCHED;
    LDB(B1, 1, 1); STB(1, 0, t + 3);
    BAR; WAIT_L(0); MMQ(0, 1, At, B1); BAR;
    LDA(At, 1, 1); STA(1, 0, t + 3);
    BAR; WAIT_L(0); MMQ(1, 0, At, B0); BAR; SCHED;
    STB(1, 1, t + 3);
    WAIT_V(6); BAR; MMQ(1, 1, At, B1); BAR;
  }
  { LDB(B0, 0, 0); LDA(At, 0, 0); STA(1, 1, nt - 1);
    BAR; WAIT_L(0); MMQ(0, 0, At, B0); BAR;
    LDB(B1, 0, 1); BAR; WAIT_L(0); MMQ(0, 1, At, B1); BAR;
    LDA(At, 0, 1); WAIT_V(4); BAR; WAIT_L(0); MMQ(1, 0, At, B0); MMQ(1, 1, At, B1); BAR; }
  { LDB(B0, 1, 0); LDA(At, 1, 0); WAIT_V(2); BAR; WAIT_L(0); MMQ(0, 0, At, B0); BAR;
    LDB(B1, 1, 1); WAIT_V(0); BAR; WAIT_L(0); MMQ(0, 1, At, B1); BAR;
    LDA(At, 1, 1); BAR; WAIT_L(0); MMQ(1, 0, At, B0); MMQ(1, 1, At, B1); BAR; }
  if (wr == 0) BAR;
  epi(acc, wr, wc, fr, fq);
}
template <class Epi>
__device__ __forceinline__ void gemm_tile(const bf16_t* A, unsigned lda, const bf16_t* Bt, unsigned ldb, int K, LAS unsigned char* lds, const Epi& epi) {
  Acc acc; gemm_tile_acc<true, false>(A, lda, Bt, ldb, K, lds, acc, epi);
}

template <int ACT> struct EpiBf16 {
  bf16_t* dst; unsigned ld; int ncols;
  __device__ __forceinline__ void operator()(Acc& acc, int wr, int wc, int fr, int fq) const {
    bf16_t* d0 = dst + (size_t)(wr * 64) * ld + wc * 32; const unsigned lo = (unsigned)(fr * ld + 4 * fq) * 2u;
#pragma unroll
    for (int ai = 0; ai < 2; ++ai)
#pragma unroll
      for (int m = 0; m < 4; ++m) {
#pragma unroll
        for (int bj = 0; bj < 2; ++bj)
#pragma unroll
          for (int n = 0; n < 2; ++n) {
            f32x4 v = acc[ai][bj][m][n];
            if (ACT == 1) { v[0] = gelu_tanh(v[0]); v[1] = gelu_tanh(v[1]); v[2] = gelu_tanh(v[2]); v[3] = gelu_tanh(v[3]); }
            if (bj * 128 + wc * 32 + n * 16 < ncols) { u32x2 w; w.x = cvtpk(v[0], v[1]); w.y = cvtpk(v[2], v[3]);
              *(u32x2*)((unsigned char*)(d0 + (size_t)(ai * 128 + m * 16) * ld + bj * 128 + n * 16) + lo) = w; }
          }
      }
  }
};
struct EpiKV {
  bf16_t* kd; bf16_t* vd;
  __device__ __forceinline__ void operator()(Acc& acc, int wr, int wc, int fr, int fq) const {
    bf16_t* k0 = kd + (size_t)(wr * 64) * 1536 + wc * 32; bf16_t* v0 = vd + (size_t)(wr * 64) * 1024 + wc * 32;
    const unsigned lk = (unsigned)(fr * 1536 + 4 * fq) * 2u, lv = (unsigned)(fr * 1024 + 4 * fq) * 2u;
#pragma unroll
    for (int ai = 0; ai < 2; ++ai)
#pragma unroll
      for (int m = 0; m < 4; ++m) {
#pragma unroll
        for (int n = 0; n < 2; ++n) {
          const f32x4 a = acc[ai][0][m][n], b = acc[ai][1][m][n];
          u32x2 w; w.x = cvtpk(a[0], a[1]); w.y = cvtpk(a[2], a[3]); *(u32x2*)((unsigned char*)(k0 + (size_t)(ai * 128 + m * 16) * 1536 + n * 16) + lk) = w;
          w.x = cvtpk(b[0], b[1]); w.y = cvtpk(b[2], b[3]); *(u32x2*)((unsigned char*)(v0 + (size_t)(ai * 128 + m * 16) * 1024 + n * 16) + lv) = w;
        }
      }
  }
};
template <bool PART> struct EpiRes {
  const float* xin; float* xout; const float* gate; int qm;
  __device__ __forceinline__ void operator()(Acc& acc, int wr, int wc, int fr, int fq) const {
    const float* g0 = gate + wc * 32 + 4 * fq;
    const float* xi0 = xin + (size_t)(wr * 64) * D + wc * 32; float* xo0 = xout + (size_t)(wr * 64) * D + wc * 32;
    const unsigned lo = (unsigned)(fr * D + 4 * fq) * 4u;
    f32x4 xa[2][2], xb[2][2], xc[2][2];
#define RES_LD(buf, gi) _Pragma("unroll") for (int bj = 0; bj < 2; ++bj) if (QON((gi) >> 2, bj)) _Pragma("unroll") for (int n = 0; n < 2; ++n) \
      buf[bj][n] = *(const f32x4*)((const char*)(xi0 + (size_t)(((gi) >> 2) * 128 + ((gi) & 3) * 16) * D + bj * 128 + n * 16) + lo)
#define RES_ST(buf, gi) _Pragma("unroll") for (int bj = 0; bj < 2; ++bj) if (QON((gi) >> 2, bj)) _Pragma("unroll") for (int n = 0; n < 2; ++n) \
      *(f32x4*)((char*)(xo0 + (size_t)(((gi) >> 2) * 128 + ((gi) & 3) * 16) * D + bj * 128 + n * 16) + lo) = buf[bj][n] + *(const f32x4*)(g0 + bj * 128 + n * 16) * acc[(gi) >> 2][bj][(gi) & 3][n]
    RES_LD(xa, 0); RES_LD(xb, 1); RES_LD(xc, 2);
    RES_ST(xa, 0); RES_LD(xa, 3);
    RES_ST(xb, 1); RES_LD(xb, 4);
    RES_ST(xc, 2); RES_LD(xc, 5);
    RES_ST(xa, 3); RES_LD(xa, 6);
    RES_ST(xb, 4); RES_LD(xb, 7);
    RES_ST(xc, 5);
    RES_ST(xa, 6);
    RES_ST(xb, 7);
#undef RES_LD
#undef RES_ST
  }
};
template <int BR, bool PART> struct EpiGateR {
  unsigned char* s0; unsigned char* s1; unsigned char* s2; int qm;
  __device__ __forceinline__ void operator()(Acc& acc, int wr, int wc, int fr, int fq) const {
    const unsigned wo = (unsigned)(wr * 4 + wc) * 16384u, lo = (unsigned)(fq * 16 + fr) * 8u;
    unsigned char* cur = (BR == 0 ? s0 : BR == 1 ? s1 : s2) + wo; unsigned char* prv = (BR == 1 ? s0 : s1) + wo;
#pragma unroll
    for (int hf = 0; hf < 4; ++hf) {
      u32x2 pw[8];
      if (BR != 0) {
#pragma unroll
        for (int q = 0; q < 8; ++q) if (QON((hf * 8 + q) >> 4, ((hf * 8 + q) >> 1) & 1)) pw[q] = *(const u32x2*)(prv + (hf * 8 + q) * 512 + lo);
      }
#pragma unroll
      for (int q = 0; q < 8; ++q) {
        const int s = hf * 8 + q, ai = s >> 4, m = (s >> 2) & 3, bj = (s >> 1) & 1, n = s & 1;
        if (!QON(ai, bj)) continue;
        const f32x4 z = acc[ai][bj][m][n]; f32x4 inv, g;
#pragma unroll
        for (int e = 0; e < 4; ++e) { inv[e] = 1.f + __expf(-fminf(fmaxf(z[e], -30.f), 30.f)); g[e] = __builtin_amdgcn_rcpf(inv[e]); }
        u32x2 w; w.x = cvtpk(g[0], g[1]); w.y = cvtpk(g[2], g[3]);
        *(u32x2*)(cur + s * 512 + lo) = w;
        if (BR != 0) { f32x4 r; r[0] = bflo(pw[q].x) * inv[0]; r[1] = bfhi(pw[q].x) * inv[1]; r[2] = bflo(pw[q].y) * inv[2]; r[3] = bfhi(pw[q].y) * inv[3];
          u32x2 o; o.x = cvtpk(r[0], r[1]); o.y = cvtpk(r[2], r[3]); *(u32x2*)(prv + s * 512 + lo) = o; }
      }
    }
  }
};
template <bool LAST, bool PART> struct EpiScale {
  const unsigned char* sl; bf16_t* y; int qm;
  __device__ __forceinline__ void operator()(Acc& acc, int wr, int wc, int fr, int fq) const {
    const unsigned char* wb = sl + (wr * 4 + wc) * 16384; const unsigned lo = (unsigned)(fq * 16 + fr) * 8u;
    bf16_t* yw = y + (size_t)(wr * 64) * D + wc * 32; const unsigned yo = (unsigned)(fr * D + 4 * fq) * 2u;
#pragma unroll
    for (int hf = 0; hf < 4; ++hf) {
      u32x2 pw[8];
#pragma unroll
      for (int q = 0; q < 8; ++q) if (QON((hf * 8 + q) >> 4, ((hf * 8 + q) >> 1) & 1)) pw[q] = *(const u32x2*)(wb + (hf * 8 + q) * 512 + lo);
#pragma unroll
      for (int q = 0; q < 8; ++q) {
        const int s = hf * 8 + q, ai = s >> 4, m = (s >> 2) & 3, bj = (s >> 1) & 1, n = s & 1;
        if (!QON(ai, bj)) continue;
        f32x4 r; r[0] = bflo(pw[q].x); r[1] = bfhi(pw[q].x); r[2] = bflo(pw[q].y); r[3] = bfhi(pw[q].y);
        const f32x4 v = acc[ai][bj][m][n] * r;
        if (!LAST) acc[ai][bj][m][n] = v;
        else { u32x2 o; o.x = cvtpk(v[0], v[1]); o.y = cvtpk(v[2], v[3]);
          *(u32x2*)((unsigned char*)(yw + (size_t)(ai * 128 + m * 16) * D + bj * 128 + n * 16) + yo) = o; }
      }
    }
  }
};
constexpr int CS = 528;
struct EpiConv {
  LAS unsigned char* shm; const float* cw; const float* cb;
  bf16_t* f; int ch0; int nvalid; int hole;
  __device__ __forceinline__ void operator()(Acc& acc, int wr, int wc, int fr, int fq) const {
    int tid = threadIdx.x; asm volatile("" : "+v"(tid)); const int cgp = tid & 15, rg = tid >> 4;
    const int ch = ch0 + cgp * 8;
    float wa[3][8], wv[3][8], ba[8], bv[8];
#pragma unroll
    for (int j = 0; j < 3; ++j)
#pragma unroll
      for (int e = 0; e < 8; e += 4) {
        const f32x4 t0 = *(const f32x4*)(cw + (long)j * F2 + ch + e), t1 = *(const f32x4*)(cw + (long)j * F2 + DFF + ch + e);
        wa[j][e] = t0[0]; wa[j][e + 1] = t0[1]; wa[j][e + 2] = t0[2]; wa[j][e + 3] = t0[3];
        wv[j][e] = t1[0]; wv[j][e + 1] = t1[1]; wv[j][e + 2] = t1[2]; wv[j][e + 3] = t1[3];
      }
#pragma unroll
    for (int e = 0; e < 8; e += 4) {
      const f32x4 t0 = *(const f32x4*)(cb + ch + e), t1 = *(const f32x4*)(cb + DFF + ch + e);
      ba[e] = t0[0]; ba[e + 1] = t0[1]; ba[e + 2] = t0[2]; ba[e + 3] = t0[3];
      bv[e] = t1[0]; bv[e + 1] = t1[1]; bv[e + 2] = t1[2]; bv[e + 3] = t1[3];
    }
#pragma unroll
    for (int ai = 0; ai < 2; ++ai)
#pragma unroll
      for (int m = 0; m < 4; ++m) {
        LAS unsigned char* rp = shm + (ai * 128 + wr * 64 + m * 16 + fr) * CS;
#pragma unroll
        for (int bj = 0; bj < 2; ++bj)
#pragma unroll
          for (int n = 0; n < 2; ++n) {
            const f32x4 v = acc[ai][bj][m][n]; u32x2 w; w.x = cvtpk(v[0], v[1]); w.y = cvtpk(v[2], v[3]);
            *(LAS u32x2*)(rp + (bj * 128 + wc * 32 + n * 16 + 4 * fq) * 2) = w;
          }
      }
    asm volatile("s_waitcnt lgkmcnt(0)" ::: "memory"); __builtin_amdgcn_s_barrier(); asm volatile("" ::: "memory");
    const int R0 = rg * 8;
    float pa[8], ca[8], na[8], pv[8], cv[8], nv[8];
    { const int rp = R0 > 0 ? R0 - 1 : 0;
      unpack8(*(const LAS u32x4*)(shm + rp * CS + cgp * 16), pa); unpack8(*(const LAS u32x4*)(shm + rp * CS + 256 + cgp * 16), pv);
      unpack8(*(const LAS u32x4*)(shm + R0 * CS + cgp * 16), ca); unpack8(*(const LAS u32x4*)(shm + R0 * CS + 256 + cgp * 16), cv); }
#pragma unroll
    for (int i = 0; i < 8; ++i) {
      const int R = R0 + i, rn = R < 255 ? R + 1 : 255;
      unpack8(*(const LAS u32x4*)(shm + rn * CS + cgp * 16), na); unpack8(*(const LAS u32x4*)(shm + rn * CS + 256 + cgp * 16), nv);
      float o[8];
#pragma unroll
      for (int e = 0; e < 8; ++e) {
        const float a = ba[e] + wa[0][e] * pa[e] + wa[1][e] * ca[e] + wa[2][e] * na[e];
        const float v = bv[e] + wv[0][e] * pv[e] + wv[1][e] * cv[e] + wv[2][e] * nv[e];
        o[e] = a * sigmoidf_(a) * v;
      }
      if (R >= 1 && R <= nvalid && !(R >= hole && R < hole + 2)) *(u32x4*)(f + (long)(R - 1 - (R >= hole + 2 ? 2 : 0)) * DFF + ch) = pack8(o);
#pragma unroll
      for (int e = 0; e < 8; ++e) { pa[e] = ca[e]; ca[e] = na[e]; pv[e] = cv[e]; cv[e] = nv[e]; }
    }
    asm volatile("s_waitcnt lgkmcnt(0)" ::: "memory"); __builtin_amdgcn_s_barrier(); asm volatile("" ::: "memory");
  }
};

__device__ __forceinline__ void phase_mod(const P& p, unsigned char* smem) {
  const int tid_ = otid(), bid_ = obid(), grd_ = ogrid(); (void)tid_; (void)bid_; (void)grd_;
  float* s = (float*)smem;
  float* red = s + 3 * 2048;
  const int tid = tid_;
  for (int i = tid; i < 3 * 2048; i += NTHR) { const int r = i >> 11, k = i & 2047; const float v = r < 2 ? p.c[r * 2048 + k] : p.c_ctx[k]; s[i] = v / (1.f + __expf(-v)); }
  __syncthreads();
  float* mod = (float*)(p.ws + OFF_MOD);
  for (int b = bid_; b < 256; b += grd_) {
    const int layer = b >> 7, col0 = (b & 127) * 96, cg4 = tid % 24, ks = tid / 24;
    float a0[4] = {0, 0, 0, 0}, a1[4] = {0, 0, 0, 0}, a2[4] = {0, 0, 0, 0};
    if (ks < 21) {
      const float* wp = p.ada_w + (size_t)layer * 2048 * 12288 + col0 + cg4 * 4;
#pragma unroll 4
      for (int k = ks; k < 2048; k += 21) {
        const f32x4 w = *(const f32x4*)(wp + (size_t)k * 12288);
        const float s0 = s[k], s1 = s[2048 + k], s2 = s[4096 + k];
#pragma unroll
        for (int j = 0; j < 4; ++j) { a0[j] += s0 * w[j]; a1[j] += s1 * w[j]; a2[j] += s2 * w[j]; }
      }
#pragma unroll
      for (int j = 0; j < 4; ++j) { red[(ks * 3 + 0) * 96 + cg4 * 4 + j] = a0[j]; red[(ks * 3 + 1) * 96 + cg4 * 4 + j] = a1[j]; red[(ks * 3 + 2) * 96 + cg4 * 4 + j] = a2[j]; }
    }
    __syncthreads();
    if (tid < 288) {
      const int r = tid / 96, cc = tid % 96; float sum = p.ada_b[layer * 12288 + col0 + cc];
      for (int k = 0; k < 21; ++k) sum += red[(k * 3 + r) * 96 + cc];
      mod[(layer * 3 + r) * 12288 + col0 + cc] = sum;
    }
    __syncthreads();
  }
}

__device__ __forceinline__ void cvt_job(const float* __restrict__ src, int ld_src, int K, int nrows, int colbase, int mode, bf16_t* dst, float* lds, int& rot) {
  const int tid_ = otid(), bid_ = obid(), grd_ = ogrid(); (void)tid_; (void)bid_; (void)grd_;
  const int tid = tid_, ntk = K >> 6, ntiles = (nrows >> 6) * ntk;
  int start = (int)bid_ - rot; if (start < 0) start += grd_;
  for (int t = start; t < ntiles; t += grd_) {
    const int nt = t / ntk, kt = t % ntk, n0 = nt * 64, k0 = kt * 64;
    const int sc0 = mode == 0 ? colbase + n0 : ((n0 >> 8) * 128 + (n0 & 127) + ((n0 >> 7) & 1) * DFF);
    const int kk = tid >> 4, c4 = (tid & 15) * 4;
#pragma unroll
    for (int i = 0; i < 2; ++i) {
      const f32x4 v = *(const f32x4*)(src + (size_t)(k0 + kk + 32 * i) * ld_src + sc0 + c4);
      float* lp = lds + (kk + 32 * i) * 65 + c4; lp[0] = v[0]; lp[1] = v[1]; lp[2] = v[2]; lp[3] = v[3];
    }
    __syncthreads();
    const int n = tid >> 3, kq = (tid & 7) * 8; float f[8];
#pragma unroll
    for (int j = 0; j < 8; ++j) f[j] = lds[(kq + j) * 65 + n];
    *(u32x4*)(dst + (size_t)(n0 + n) * K + k0 + kq) = pack8(f);
    __syncthreads();
  }
  rot = (rot + ntiles) % (int)grd_;
}
__device__ __forceinline__ void phase_cvt(const P& p, int layer, unsigned char* smem) {
  const int tid_ = otid(), bid_ = obid(), grd_ = ogrid(); (void)tid_; (void)bid_; (void)grd_;
  float* lds = (float*)smem; bf16_t* WB = (bf16_t*)(p.ws + OFF_WB); int rot = 0;
  const float* w_in = p.w_in + (size_t)layer * D * INC;
  cvt_job(w_in, INC, D, 1344, 0, 0, WB + W_SM, lds, rot);
  cvt_job(w_in, INC, D, 1024, 1344, 0, WB + W_SM + (size_t)1536 * D, lds, rot);
  cvt_job(w_in, INC, D, 6144, 2368, 0, WB + W_G, lds, rot);
  cvt_job(p.w_uq + (size_t)layer * 512 * 1536, 1536, 512, 1536, 0, 0, WB + W_UQ, lds, rot);
  cvt_job(p.w_ukv + (size_t)layer * 256 * 2048, 2048, 256, 2048, 0, 0, WB + W_UKV, lds, rot);
  for (int g = 0; g < 4; ++g) cvt_job(p.pool_w + ((size_t)layer * 4 + g) * 16384, 128, 128, 128, 0, 0, WB + W_POOL + g * 16384, lds, rot);
  cvt_job(p.w_br_pool + (size_t)layer * 512 * D, D, 512, D, 0, 0, WB + W_BP, lds, rot);
  cvt_job(p.w_br_mla + (size_t)layer * 1024 * D, D, 1024, D, 0, 0, WB + W_BM, lds, rot);
  cvt_job(p.w_br_sg + (size_t)layer * 512 * D, D, 512, D, 0, 0, WB + W_BS, lds, rot);
  cvt_job(p.w_o + (size_t)layer * D * D, D, D, D, 0, 0, WB + W_O, lds, rot);
  cvt_job(p.ffn_up + (size_t)layer * D * F2, F2, D, F2, 0, 1, WB + W_UP, lds, rot);
  cvt_job(p.ffn_down + (size_t)layer * DFF * D, D, DFF, D, 0, 0, WB + W_DN, lds, rot);
  const size_t gt = (size_t)bid_ * NTHR + tid_, gs = (size_t)grd_ * NTHR;
  unsigned zz = 0u; asm volatile("" : "+v"(zz));
  for (size_t i = gt; i < (size_t)192 * D / 8; i += gs) *(u32x4*)(WB + W_SM + (size_t)1344 * D + i * 8) = (u32x4){zz, zz, zz, zz};
  const float* sgw = p.sg_w + (size_t)layer * 65536;
  for (size_t i = gt; i < 65536 / 8; i += gs) { float f[8]; const f32x4 a = *(const f32x4*)(sgw + i * 8), b = *(const f32x4*)(sgw + i * 8 + 4);
    f[0] = a[0]; f[1] = a[1]; f[2] = a[2]; f[3] = a[3]; f[4] = b[0]; f[5] = b[1]; f[6] = b[2]; f[7] = b[3]; *(u32x4*)(WB + W_SG + i * 8) = pack8(f); }
}

__device__ __forceinline__ void phase_norm(const float* xlat, const float* xctx, const float* g, const float* modl, int shc, int scc, bf16_t* H, bool padded, int nrows) {
  const int tid_ = otid(), bid_ = obid(), grd_ = ogrid(); (void)tid_; (void)bid_; (void)grd_;
  const int lane = tid_ & 63, gw = bid_ * 8 + (tid_ >> 6), nw = grd_ * 8;
  for (int r = gw; r < nrows; r += nw) {
    const float* src = r < NLAT ? xlat + (size_t)r * D : xctx + (size_t)(r - NLAT) * D;
    const float* mr = modl + mod_row(r) * 12288;
    float xv[32]; float ss = 0.f;
#pragma unroll
    for (int j = 0; j < 4; ++j) {
      const f32x4 a = *(const f32x4*)(src + j * 512 + lane * 8), b = *(const f32x4*)(src + j * 512 + lane * 8 + 4);
#pragma unroll
      for (int e = 0; e < 4; ++e) { xv[j * 8 + e] = a[e]; xv[j * 8 + 4 + e] = b[e]; ss += a[e] * a[e] + b[e] * b[e]; }
    }
    ss = wave_sum(ss);
    const float rr = rsqrtf(ss * (1.f / D) + EPS);
    size_t drow;
    if (!padded) drow = r;
    else drow = r < NLAT ? (size_t)(r >> 14) * HP_LAT + 1 + (r & (SEQ - 1)) : (size_t)HP_CTX0 + ((r - NLAT) >> 8) * HP_CTX + 1 + ((r - NLAT) & 255);
#pragma unroll
    for (int j = 0; j < 4; ++j) {
      const int c = j * 512 + lane * 8; float o[8];
#pragma unroll
      for (int e = 0; e < 8; e += 4) {
        const f32x4 gg = *(const f32x4*)(g + c + e), sh = *(const f32x4*)(mr + shc * 2048 + c + e), sc = *(const f32x4*)(mr + scc * 2048 + c + e);
#pragma unroll
        for (int q = 0; q < 4; ++q) o[e + q] = xv[j * 8 + e + q] * rr * gg[q] * (1.f + sc[q]) + sh[q];
      }
      *(u32x4*)(H + drow * D + c) = pack8(o);
    }
  }
  if (padded && bid_ == 0) {
    const int tid = tid_;
    for (int i = tid; i < 8 * (D / 8); i += NTHR) {
      const int z = i / (D / 8), c = (i % (D / 8)) * 8;
      const size_t row = z < 4 ? (size_t)(z >> 1) * HP_LAT + (z & 1) * (SEQ + 1) : (size_t)HP_CTX0 + ((z - 4) >> 1) * HP_CTX + (z & 1) * (CTX + 1);
      unsigned zz = 0u; asm volatile("" : "+v"(zz));
      *(u32x4*)(H + row * D + c) = (u32x4){zz, zz, zz, zz};
    }
  }
}

__device__ __forceinline__ void phase_prep(const P& p, int layer, unsigned char* smem) {
  const int tid_ = otid(), bid_ = obid(), grd_ = ogrid(); (void)tid_; (void)bid_; (void)grd_;
  bf16_t* ACT = (bf16_t*)(p.ws + OFF_ACT);
  const int lane = tid_ & 63, wv = tid_ >> 6, gw = bid_ * 8 + wv, nw = grd_ * 8;
  float gq[8], gkv[4];
#pragma unroll
  for (int e = 0; e < 8; ++e) gq[e] = p.q_lat_g[layer * 512 + lane * 8 + e];
#pragma unroll
  for (int e = 0; e < 4; ++e) gkv[e] = p.kv_lat_g[layer * 256 + lane * 4 + e];
  for (int r = gw; r < MT; r += nw) {
    { const int s0 = r < NLAT ? (r & ~(SEQ - 1)) : NLAT + ((r - NLAT) & ~255), Ls = r < NLAT ? SEQ : CTX, t = r - s0;
      const int half = 1 << (lane >> 4); const int lo = max(t - half, 0), hi = min(t + half, Ls);
      float sum[8] = {0, 0, 0, 0, 0, 0, 0, 0}, zc[8];
      u32x4 wv_[16];
#pragma unroll
      for (int i = 0; i < 16; ++i) { const int tt = min(lo + i, hi - 1); wv_[i] = *(const u32x4*)(ACT + A_ZPOOL + (size_t)(s0 + tt) * 512 + lane * 8); }
#pragma unroll
      for (int i = 0; i < 16; ++i) { float f[8]; unpack8(wv_[i], f); const float on = (lo + i < hi) ? 1.f : 0.f;
#pragma unroll
        for (int e = 0; e < 8; ++e) sum[e] += on * f[e]; }
      unpack8(*(const u32x4*)(ACT + A_ZPOOL + (size_t)r * 512 + lane * 8), zc);
      const float ic = 1.f / (float)(hi - lo);
#pragma unroll
      for (int e = 0; e < 8; ++e) sum[e] = sum[e] * ic - zc[e];
      *(u32x4*)(ACT + A_POOLED + (size_t)r * 512 + lane * 8) = pack8(sum); }
    { float f[8]; bf16_t* zp = ACT + A_ZQ + (size_t)r * 512 + lane * 8; unpack8(*(const u32x4*)zp, f); float ss = 0.f;
#pragma unroll
      for (int e = 0; e < 8; ++e) ss += f[e] * f[e];
      ss = wave_sum(ss); const float rr = rsqrtf(ss * (1.f / 512) + EPS);
#pragma unroll
      for (int e = 0; e < 8; ++e) f[e] = f[e] * rr * gq[e];
      *(u32x4*)zp = pack8(f); }
    { bf16_t* zp = ACT + A_ZKV + (size_t)r * 256 + lane * 4; const u32x2 w = *(const u32x2*)zp;
      float f0 = bflo(w.x), f1 = bfhi(w.x), f2 = bflo(w.y), f3 = bfhi(w.y);
      float ss = wave_sum(f0 * f0 + f1 * f1 + f2 * f2 + f3 * f3); const float rr = rsqrtf(ss * (1.f / 256) + EPS);
      u32x2 o; o.x = cvtpk(f0 * rr * gkv[0], f1 * rr * gkv[1]); o.y = cvtpk(f2 * rr * gkv[2], f3 * rr * gkv[3]); *(u32x2*)zp = o; }
  }
  float gs8[8];
#pragma unroll
  for (int e = 0; e < 8; ++e) gs8[e] = p.sg_norm_g[layer * 512 + lane * 8 + e];
  for (int ci = bid_; ci < MT / 128; ci += grd_) {
    bf16_t* base = ACT + A_VG + (size_t)ci * 65536;
    for (int q = wv * 16; q < wv * 16 + 16; ++q) {
      float f[8]; unpack8(*(const u32x4*)(base + (size_t)q * 512 + lane * 8), f);
      float s = 0.f;
#pragma unroll
      for (int e = 0; e < 8; ++e) s += f[e];
      const float mean = wave_sum(s) * (1.f / 512); float v = 0.f;
#pragma unroll
      for (int e = 0; e < 8; ++e) { f[e] -= mean; v += f[e] * f[e]; }
      const float rs = rsqrtf(wave_sum(v) * (1.f / 512) + EPS);
#pragma unroll
      for (int e = 0; e < 8; e += 2) { const unsigned w = cvtpk(f[e] * rs * gs8[e], f[e + 1] * rs * gs8[e + 1]);
        *(bf16_t*)(smem + ((lane * 8 + e) * 130 + q) * 2) = (bf16_t)(w & 0xffff); *(bf16_t*)(smem + ((lane * 8 + e + 1) * 130 + q) * 2) = (bf16_t)(w >> 16); }
    }
    __syncthreads();
    for (int i = tid_; i < 8192; i += NTHR) {
      const int ch = i >> 4, q0 = (i & 15) * 8; const unsigned* lp = (const unsigned*)(smem + (ch * 130 + q0) * 2);
      u32x4 w; w.x = lp[0]; w.y = lp[1]; w.z = lp[2]; w.w = lp[3];
      *(u32x4*)(base + (size_t)ch * 128 + q0) = w;
    }
    __syncthreads();
  }
}

template <class F>
__device__ __forceinline__ void small_gemm(const bf16_t* A, long lda, const bf16_t* Bt, long ldb, int fr, int fq, F epi) {
  bf16x8 a[2][4];
#pragma unroll
  for (int mi = 0; mi < 2; ++mi)
#pragma unroll
    for (int ks = 0; ks < 4; ++ks) a[mi][ks] = *(const bf16x8*)(A + (long)(mi * 16 + fr) * lda + ks * 32 + fq * 8);
#pragma unroll 2
  for (int nj = 0; nj < 8; ++nj) {
    bf16x8 b[4];
#pragma unroll
    for (int ks = 0; ks < 4; ++ks) b[ks] = *(const bf16x8*)(Bt + (long)(nj * 16 + fr) * ldb + ks * 32 + fq * 8);
#pragma unroll
    for (int mi = 0; mi < 2; ++mi) {
      f32x4 c = {0.f, 0.f, 0.f, 0.f};
#pragma unroll
      for (int ks = 0; ks < 4; ++ks) c = __builtin_amdgcn_mfma_f32_16x16x32_bf16(b[ks], a[mi][ks], c, 0, 0, 0);
      epi(mi, nj, c);
    }
  }
}
__device__ __forceinline__ void phase_small(const P& p, int layer) {
  const int tid_ = otid(), bid_ = obid(), grd_ = ogrid(); (void)tid_; (void)bid_; (void)grd_;
  bf16_t* ACT = (bf16_t*)(p.ws + OFF_ACT); const bf16_t* WB = (const bf16_t*)(p.ws + OFF_WB);
  const int lane = tid_ & 63, fr = lane & 15, fq = lane >> 4, gw = bid_ * 8 + (tid_ >> 6), nw = grd_ * 8;
#pragma unroll 1
  for (int it = gw; it < (MT / 32) * 4; it += nw) {
    const int g = it & 3, r0 = (it >> 2) * 32;
    const float* psc = p.pool_scale + layer * 512 + g * 128 + 4 * fq; bf16_t* op = ACT + A_ZPOOL + (size_t)(r0 + fr) * 512 + g * 128 + 4 * fq;
    small_gemm(ACT + A_POOLED + (size_t)r0 * 512 + g * 128, 512, WB + W_POOL + g * 16384, 128, fr, fq, [&](int mi, int nj, f32x4 c) {
      const f32x4 v = c * *(const f32x4*)(psc + nj * 16); u32x2 w; w.x = cvtpk(v[0], v[1]); w.y = cvtpk(v[2], v[3]);
      *(u32x2*)(op + (size_t)mi * 16 * 512 + nj * 16) = w; });
  }
#pragma unroll 1
  for (int it = gw; it < (MT / 128) * 16; it += nw) {
    const int pb = it & 3, g = (it >> 2) & 3, ci = it >> 4;
    const float* bp = p.sg_b + (layer * 4 + g) * 128 + pb * 32 + fr; bf16_t* up = ACT + A_U + (size_t)(ci * 128 + pb * 32 + fr) * 512 + g * 128 + 4 * fq;
    const float bb0 = bp[0], bb1 = bp[16];
    small_gemm(WB + W_SG + g * 16384 + pb * 32 * 128, 128, ACT + A_VG + (size_t)ci * 65536 + g * 16384, 128, fr, fq, [&](int mi, int nj, f32x4 s) {
      const float bb = mi ? bb1 : bb0; bf16_t* q = up + (size_t)mi * 16 * 512 + nj * 16; const u32x2 uw = *(const u32x2*)q;
      u32x2 w; w.x = cvtpk(bflo(uw.x) * (s[0] + bb), bfhi(uw.x) * (s[1] + bb)); w.y = cvtpk(bflo(uw.y) * (s[2] + bb), bfhi(uw.y) * (s[3] + bb));
      *(u32x2*)q = w; });
  }
}

__device__ __forceinline__ void rope8(float* y, int j, int t, bool on) {
  if (!on) return;
  const int axis = j >> 2, half = (j >> 1) & 1; const float pos = (float)(axis ? (t & 63) : (t >> 6));
#pragma unroll
  for (int e = 0; e < 8; ++e) {
    const int f = (j & 1) * 8 + e;
    const float rev = pos * (exp2f(-0.8304820237218406f * (float)f) * 0.15915494309189535f);
    const float sn = __builtin_amdgcn_sinf(rev), cs = __builtin_amdgcn_cosf(rev);
    const float pr = __shfl_xor(y[e], 2);
    y[e] = half ? y[e] * cs + pr * sn : y[e] * cs - pr * sn;
  }
}
__device__ __forceinline__ void phase_qk(const P& p, int layer) {
  const int tid_ = otid(), bid_ = obid(), grd_ = ogrid(); (void)tid_; (void)bid_; (void)grd_;
  bf16_t* ACT = (bf16_t*)(p.ws + OFF_ACT);
  const int lane = tid_ & 63, h = lane >> 3, j = lane & 7, gw = bid_ * 8 + (tid_ >> 6), nw = grd_ * 8;
  float qg[3][8], kg[3][8];
#pragma unroll
  for (int i = 0; i < 3; ++i)
#pragma unroll
    for (int e = 0; e < 8; ++e) { qg[i][e] = p.q_norm_g[layer * 192 + i * 64 + j * 8 + e]; kg[i][e] = p.k_norm_g[layer * 192 + i * 64 + j * 8 + e]; }
  for (int r = gw; r < MT; r += nw) {
    const bool lat = r < NLAT; const int t = r & (SEQ - 1);
    if (lat || layer == 0) {
      bf16_t* qp = ACT + A_Q + (size_t)r * 1536 + h * 192 + j * 8; float y[3][8]; float ss = 0.f;
#pragma unroll
      for (int i = 0; i < 3; ++i) { unpack8(*(const u32x4*)(qp + i * 64), y[i]);
#pragma unroll
        for (int e = 0; e < 8; ++e) ss += y[i][e] * y[i][e]; }
      ss += __shfl_xor(ss, 1); ss += __shfl_xor(ss, 2); ss += __shfl_xor(ss, 4);
      const float rr = rsqrtf(ss * (1.f / 192) + EPS);
#pragma unroll
      for (int i = 0; i < 3; ++i)
#pragma unroll
        for (int e = 0; e < 8; ++e) y[i][e] *= rr * qg[i][e];
      rope8(y[2], j, t, lat);
#pragma unroll
      for (int i = 0; i < 3; ++i) *(u32x4*)(qp + i * 64) = pack8(y[i]);
    }
    {
      bf16_t* kp = ACT + A_K + (size_t)kv_row(r) * 1536 + h * 192 + j * 8; float y[3][8]; float ss = 0.f;
      unpack8(*(const u32x4*)(kp), y[0]); unpack8(*(const u32x4*)(kp + 64), y[1]); unpack8(*(const u32x4*)(ACT + A_ZKR + (size_t)r * 64 + j * 8), y[2]);
#pragma unroll
      for (int i = 0; i < 3; ++i)
#pragma unroll
        for (int e = 0; e < 8; ++e) ss += y[i][e] * y[i][e];
      ss += __shfl_xor(ss, 1); ss += __shfl_xor(ss, 2); ss += __shfl_xor(ss, 4);
      const float rr = rsqrtf(ss * (1.f / 192) + EPS);
#pragma unroll
      for (int i = 0; i < 3; ++i)
#pragma unroll
        for (int e = 0; e < 8; ++e) y[i][e] *= rr * kg[i][e];
      rope8(y[2], j, t, lat);
#pragma unroll
      for (int i = 0; i < 3; ++i) *(u32x4*)(kp + i * 64) = pack8(y[i]);
    }
  }
}

constexpr int LDQ = 1536, LDK = 1536, LDV = 1024, LDO = 1024;
constexpr float ASCALE = 0.07216878364870322f;
constexpr float ATHR = 8.f;
constexpr int SHM_V = 64 * 128 * 2, SHM_K = 64 * 192 * 2;
#define KADDR(row, ch24) (((ch24) >> 3) * 8192 + (row) * 128 + (((((ch24) & 7)) ^ (((row) >> 1) & 7)) << 4))
#define SBAR() __builtin_amdgcn_sched_barrier(0)
__device__ __forceinline__ int crow(int r, int hi) { return (r & 3) + 8 * (r >> 2) + 4 * hi; }
__device__ __forceinline__ void partialSM(f32x16& p0, f32x16& p1, float& m_reg, float& mn, float& alpha) {
  constexpr float C = ASCALE * 1.4426950408889634f;
  float pmax = p0[0];
#pragma unroll
  for (int r = 1; r < 16; ++r) pmax = fmaxf(pmax, p0[r]);
#pragma unroll
  for (int r = 0; r < 16; ++r) pmax = fmaxf(pmax, p1[r]);
  { auto rr = __builtin_amdgcn_permlane32_swap(__float_as_uint(pmax), __float_as_uint(pmax), false, false);
    pmax = fmaxf(__uint_as_float(rr[0]), __uint_as_float(rr[1])); }
  if (__builtin_expect(__all(pmax - m_reg <= ATHR / ASCALE), 1)) { mn = m_reg; alpha = 1.f; }
  else { mn = fmaxf(m_reg, pmax); alpha = __builtin_amdgcn_exp2f((m_reg - mn) * C); m_reg = mn; }
  const float mnC = -mn * C;
#pragma unroll
  for (int r = 0; r < 16; ++r) p0[r] = fmaf(p0[r], C, mnC);
#pragma unroll
  for (int r = 0; r < 16; ++r) p1[r] = fmaf(p1[r], C, mnC);
#pragma unroll
  for (int r = 0; r < 16; ++r) p0[r] = __builtin_amdgcn_exp2f(p0[r]);
}
__device__ __forceinline__ void finishSM(f32x16& p0, f32x16& p1, float alpha, float& l_reg, bf16x8& pa0, bf16x8& pa1, bf16x8& pa2, bf16x8& pa3) {
#pragma unroll
  for (int r = 0; r < 16; ++r) p1[r] = __builtin_amdgcn_exp2f(p1[r]);
  float ps = 0;
#pragma unroll
  for (int r = 0; r < 16; ++r) ps += p0[r];
#pragma unroll
  for (int r = 0; r < 16; ++r) ps += p1[r];
  { auto rr = __builtin_amdgcn_permlane32_swap(__float_as_uint(ps), __float_as_uint(ps), false, false);
    ps = __uint_as_float(rr[0]) + __uint_as_float(rr[1]); }
  l_reg = l_reg * alpha + ps;
#define PK4(Pv, BASE, OUT) do { unsigned a0 = cvtpk(Pv[BASE + 0], Pv[BASE + 1]), a1 = cvtpk(Pv[BASE + 2], Pv[BASE + 3]);   \
    unsigned b0 = cvtpk(Pv[BASE + 4], Pv[BASE + 5]), b1 = cvtpk(Pv[BASE + 6], Pv[BASE + 7]);                              \
    auto r0 = __builtin_amdgcn_permlane32_swap(a0, b0, false, false); auto r1 = __builtin_amdgcn_permlane32_swap(a1, b1, false, false); \
    u32x4 w = {r0[0], r1[0], r0[1], r1[1]}; OUT = *reinterpret_cast<bf16x8*>(&w); } while (0)
  PK4(p0, 0, pa0); PK4(p0, 8, pa1); PK4(p1, 0, pa2); PK4(p1, 8, pa3);
#undef PK4
}
__device__ __forceinline__ void qkt(f32x16& p0, f32x16& p1, const LAS unsigned char* Ks, const bf16x8* qr, const int* kb) {
  p0 = f32x16{}; p1 = f32x16{};
#pragma unroll
  for (int d0 = 0; d0 < 12; ++d0) {
    const bf16x8 b0 = *(const LAS bf16x8*)(Ks + kb[d0 & 3] + (d0 >> 2) * 8192);
    const bf16x8 b1 = *(const LAS bf16x8*)(Ks + kb[d0 & 3] + (d0 >> 2) * 8192 + 4096);
    p0 = __builtin_amdgcn_mfma_f32_32x32x16_bf16(b0, qr[d0], p0, 0, 0, 0);
    p1 = __builtin_amdgcn_mfma_f32_32x32x16_bf16(b1, qr[d0], p1, 0, 0, 0); }
}
__device__ __forceinline__ int v_st(int k, int c) { const int kk = (k & ~0xC) | ((k & 4) << 1) | ((k & 8) >> 1); return ((kk >> 3) * 4 + (c >> 5)) * 512 + ((kk & 7) * 32 + (c & 31)) * 2; }
__device__ __forceinline__ int v_rd_base(int lane) { return ((lane & 3) << 3) | (((lane >> 2) & 3) << 6) | (((lane >> 4) & 1) << 5) | (((lane >> 5) & 1) << 8); }
constexpr int v_rd_off(int d0, int ks, int half) { return d0 * 512 + ks * 4096 + half * 2048; }
template <int OFF> __device__ __forceinline__ s16x4 tr_read(int vb) {
  s16x4 r; asm volatile("ds_read_b64_tr_b16 %0, %1 offset:%2" : "=&v"(r) : "v"(vb), "i"(OFF) : "memory"); return r;
}
template <int D0> __device__ __forceinline__ void pv_one(f32x16& od, int vb, bf16x8 pa0, bf16x8 pa1, bf16x8 pa2, bf16x8 pa3) {
  const s16x4 l0 = tr_read<v_rd_off(D0, 0, 0)>(vb), h0 = tr_read<v_rd_off(D0, 0, 1)>(vb), l1 = tr_read<v_rd_off(D0, 1, 0)>(vb), h1 = tr_read<v_rd_off(D0, 1, 1)>(vb);
  const s16x4 l2 = tr_read<v_rd_off(D0, 2, 0)>(vb), h2 = tr_read<v_rd_off(D0, 2, 1)>(vb), l3 = tr_read<v_rd_off(D0, 3, 0)>(vb), h3 = tr_read<v_rd_off(D0, 3, 1)>(vb);
  asm volatile("s_waitcnt lgkmcnt(0)" ::: "memory"); SBAR();
#define PKV(Lo, Hi) (bf16x8){Lo[0], Lo[1], Lo[2], Lo[3], Hi[0], Hi[1], Hi[2], Hi[3]}
  od = __builtin_amdgcn_mfma_f32_32x32x16_bf16(pa0, PKV(l0, h0), od, 0, 0, 0);
  od = __builtin_amdgcn_mfma_f32_32x32x16_bf16(pa1, PKV(l1, h1), od, 0, 0, 0);
  od = __builtin_amdgcn_mfma_f32_32x32x16_bf16(pa2, PKV(l2, h2), od, 0, 0, 0);
  od = __builtin_amdgcn_mfma_f32_32x32x16_bf16(pa3, PKV(l3, h3), od, 0, 0, 0);
#undef PKV
}
__device__ __forceinline__ void pv_d0(f32x16* o, int vb, bf16x8 pa0, bf16x8 pa1, bf16x8 pa2, bf16x8 pa3) {
  pv_one<0>(o[0], vb, pa0, pa1, pa2, pa3); pv_one<1>(o[1], vb, pa0, pa1, pa2, pa3); pv_one<2>(o[2], vb, pa0, pa1, pa2, pa3); pv_one<3>(o[3], vb, pa0, pa1, pa2, pa3);
}
__device__ __forceinline__ void attn_unit(const bf16_t* Qb, const bf16_t* Kh, const bf16_t* Vh, bf16_t* Ob, int seq, LAS unsigned char* lds) {
  const int tid_ = otid(), bid_ = obid(), grd_ = ogrid(); (void)tid_; (void)bid_; (void)grd_;
  const int tid = tid_, wid = __builtin_amdgcn_readfirstlane(tid >> 6), lane = tid & 63, r32 = lane & 31, hi = lane >> 5;
  LAS unsigned char* V_lds = lds; LAS unsigned char* K_lds = lds + 3 * SHM_V;
  LAS float* wsl = (LAS float*)(lds + 3 * SHM_V + 3 * SHM_K) + wid * 64; LAS float* li_l = wsl; LAS float* al_l = wsl + 32;
  float m_reg = -1e30f, l_reg = 0; f32x16 o[4] = {}; bf16x8 qr[12];
  { const bf16_t* Qw = Qb + (size_t)(wid * 32) * LDQ; const unsigned qo = (unsigned)(r32 * LDQ + hi * 8) * 2u;
#pragma unroll
    for (int d0 = 0; d0 < 12; ++d0) qr[d0] = *(const bf16x8*)((const char*)Qw + qo + d0 * 32); }
  unsigned kgo[3], vgo[2];
#pragma unroll
  for (int i = 0; i < 3; ++i) { const int pu = (i * 8 + wid) * 64 + lane, sub = pu >> 9, row = (pu >> 3) & 63, pc = pu & 7, cch = pc ^ ((row >> 1) & 7);
    kgo[i] = (unsigned)(row * LDK + (sub * 8 + cch) * 8) * 2u; }
#pragma unroll
  for (int i = 0; i < 2; ++i) { const int u = (i * 8 + wid) * 64 + lane, st = u >> 5, kk = ((st >> 2) << 3) | ((u >> 2) & 7), cc = ((st & 3) << 5) | ((u & 3) << 3);
    const int k = (kk & ~0xC) | ((kk & 4) << 1) | ((kk & 8) >> 1); vgo[i] = (unsigned)(k * LDV + cc) * 2u; }
  int kb[4];
#pragma unroll
  for (int q = 0; q < 4; ++q) kb[q] = r32 * 128 + (((q * 2 + hi) ^ ((r32 >> 1) & 7)) << 4);
  const int vb0 = (int)(uintptr_t)V_lds + v_rd_base(lane);
  const char* Kt = (const char*)Kh; const char* Vt = (const char*)Vh;
#define DMA(b) do { \
    _Pragma("unroll") for (int _i = 0; _i < 3; ++_i) __builtin_amdgcn_global_load_lds((const unsigned*)(Kt + kgo[_i]), (LAS unsigned*)(K_lds + (b) * SHM_K + (_i * 8 + wid) * 1024), 16, 0, 0); \
    _Pragma("unroll") for (int _i = 0; _i < 2; ++_i) __builtin_amdgcn_global_load_lds((const unsigned*)(Vt + vgo[_i]), (LAS unsigned*)(V_lds + (b) * SHM_V + (_i * 8 + wid) * 1024), 16, 0, 0); \
    Kt += 64 * LDK * 2; Vt += 64 * LDV * 2; } while (0)
#define VMW() asm volatile("s_waitcnt vmcnt(0)" ::: "memory")
#define RESC(a) do { if (__any((a) < 1.f)) { if (hi == 0) al_l[r32] = (a); asm volatile("s_waitcnt lgkmcnt(0)" ::: "memory"); \
    _Pragma("unroll") for (int d = 0; d < 4; ++d) _Pragma("unroll") for (int r = 0; r < 16; ++r) o[d][r] *= al_l[crow(r, hi)]; } } while (0)
  f32x16 pA0, pA1; float mnA, alA; bf16x8 pa0, pa1, pa2, pa3; const int NT = seq / 64;
  int bc = 0, bn = 1, bf = 2;
  DMA(0); DMA(1); asm volatile("s_waitcnt vmcnt(5)" ::: "memory"); __builtin_amdgcn_s_barrier(); asm volatile("" ::: "memory");
#pragma unroll 1
  for (int t = 0; t < NT; ++t) {
    const bool more = t + 2 < NT;
    if (more) DMA(bf);
    SBAR();
    qkt(pA0, pA1, K_lds + bc * SHM_K, qr, kb); partialSM(pA0, pA1, m_reg, mnA, alA);
    finishSM(pA0, pA1, alA, l_reg, pa0, pa1, pa2, pa3); RESC(alA); SBAR();
    pv_d0(o, vb0 + bc * SHM_V, pa0, pa1, pa2, pa3);
    if (more) asm volatile("s_waitcnt vmcnt(5) lgkmcnt(0)" ::: "memory"); else asm volatile("s_waitcnt vmcnt(0) lgkmcnt(0)" ::: "memory");
    __builtin_amdgcn_s_barrier(); asm volatile("" ::: "memory");
    { const int x = bc; bc = bn; bn = bf; bf = x; }
  }
  if (hi == 0) li_l[r32] = l_reg; asm volatile("s_waitcnt lgkmcnt(0)" ::: "memory");
  bf16_t* Ow = Ob + (size_t)(wid * 32) * LDO;
#pragma unroll
  for (int r = 0; r < 16; ++r) { const int orow = crow(r, hi); const float rl = __builtin_amdgcn_rcpf(li_l[orow]);
#pragma unroll
    for (int d0 = 0; d0 < 4; ++d0) Ow[orow * LDO + d0 * 32 + r32] = (bf16_t)(cvtpk(o[d0][r] * rl, 0.f) & 0xffff); }
  __syncthreads();
#undef DMA
#undef VMW
#undef RESC
}
__device__ __forceinline__ void phase_attn(const P& p, int layer, unsigned char* smem) {
  const int tid_ = otid(), bid_ = obid(), grd_ = ogrid(); (void)tid_; (void)bid_; (void)grd_;
  bf16_t* ACT = (bf16_t*)(p.ws + OFF_ACT);
  const int G = grd_, c = bid_;
  for (int u = c; u < 1024; u += G) {
    int bh, qb;
    if (G == 256) { const int i = u >> 8, x = c & 7, j = c >> 3; bh = i * 4 + (x >> 1); qb = (x & 1) * 32 + j; } else { bh = u >> 6; qb = u & 63; }
    const int b = bh >> 3, h = bh & 7; const size_t qrow = (size_t)b * SEQ + qb * 256, krow = (size_t)b * KVS;
    attn_unit(ACT + A_Q + qrow * LDQ + h * 192, ACT + A_K + krow * LDK + h * 192, ACT + A_V + krow * LDV + h * 128, ACT + A_ATT + qrow * LDO + h * 128, KVS, (LAS unsigned char*)smem);
  }
  if (layer == 0) for (int u = c; u < 16; u += G) {
    const int b = u >> 3, h = u & 7; const size_t qrow = (size_t)NLAT + b * CTX, krow = (size_t)b * KVS + SEQ;
    attn_unit(ACT + A_Q + qrow * LDQ + h * 192, ACT + A_K + krow * LDK + h * 192, ACT + A_V + krow * LDV + h * 128, ACT + A_ATT + qrow * LDO + h * 128, CTX, (LAS unsigned char*)smem);
  }
}

#ifndef TESTMASK
#define TESTMASK 0xFFFF
#endif
#define RUNPH(n) ((TESTMASK >> (n)) & 1)
template <unsigned MASK = 0x3fffffffu>
__device__ __forceinline__ P load_params() {
  P r{}; const volatile __attribute__((address_space(4))) unsigned long long* kp = (const volatile __attribute__((address_space(4))) unsigned long long*)__builtin_amdgcn_kernarg_segment_ptr();
  const float** d = (const float**)&r;
#pragma unroll
  for (int i = 0; i < 30; ++i) if ((MASK >> i) & 1u) d[i] = (const float*)(const __attribute__((address_space(1))) float*)kp[i];
  return r;
}
constexpr unsigned M_WS = 1u << 29, M_OUT = 1u << 28, M_IO = M_WS | M_OUT | 1u | (1u << 2);
__device__ __forceinline__ int opq(int v) { asm volatile("" : "+s"(v)); return v; }
#define ENV() const int G = ogrid(), c = obid(); (void)G; (void)c; const P p = load_params<M_IO | (1u << 6) | (1u << 23) | (1u << 25) | (1u << 26)>(); bf16_t* ACT = (bf16_t*)(p.ws + OFF_ACT); const bf16_t* WB = (const bf16_t*)(p.ws + OFF_WB); bf16_t* H = (bf16_t*)(p.ws + OFF_H); \
  float* XC = (float*)(p.ws + OFF_XC); const float* modl = (const float*)(p.ws + OFF_MOD) + layer * 3 * 12288; \
  const float* xlat = layer ? p.out : p.x; const float* xctx = layer ? XC : p.ctx; (void)ACT; (void)WB; (void)H; (void)XC; (void)modl; (void)xlat; (void)xctx;

#ifndef DBG_MERGE
#define DBG_MERGE 0
#endif
#ifndef DBG_STOP
#define DBG_STOP 0
#endif
__device__ __forceinline__ void dbg_dump(const bf16_t* src, size_t nelem, const bf16_t* src2 = nullptr, size_t nelem2 = 1) {
  const P p = load_params<M_OUT>(); const size_t n = (size_t)NLAT * D;
  for (size_t i = (size_t)blockIdx.x * NTHR + threadIdx.x; i < n; i += (size_t)gridDim.x * NTHR)
    p.out[i] = (src2 && i >= n / 2) ? bflo((unsigned)src2[(i - n / 2) % nelem2]) : bflo((unsigned)src[i % nelem]);
}
#define DBG(k, off, ne) if (DBG_STOP == (k) && layer == 0) { dbg_dump((const bf16_t*)(load_params<M_WS>().ws + OFF_ACT) + (off), (ne)); return; }
__global__ void __launch_bounds__(NTHR, 2) mega(P p_arg) {
  extern __shared__ __attribute__((aligned(16))) unsigned char smem[];
  cg::grid_group grid = cg::this_grid();
  unsigned nbar = 0;
#define GSYNC() do { ++nbar; grid_barrier((unsigned*)(load_params<M_WS>().ws + OFF_CTL), nbar * gridDim.x); } while (0)
  LAS unsigned char* lds3 = (LAS unsigned char*)smem;

  grid.sync();
  if (RUNPH(0)) { const P p = load_params(); phase_mod(p, smem); phase_cvt(p, 0, smem); }
  GSYNC();

#pragma unroll 1
  for (int layer = 0; layer < 2; ++layer) {
    const int nMr = layer == 0 ? 130 : 128;
    if (RUNPH(0)) if (layer == 1) { const P p = load_params(); phase_cvt(p, 1, smem); }
    if (RUNPH(1)) { ENV(); phase_norm(xlat, xctx, p.norm1_g + layer * D, modl, 0, 1, H, false, MT); }
    GSYNC();
    if (DBG_STOP == 8 && layer == 0) { dbg_dump((const bf16_t*)(load_params<M_WS>().ws + OFF_WB), W_END); return; }
    if (DBG_STOP == 9 && layer == 0) { dbg_dump((const bf16_t*)(load_params<M_WS>().ws + OFF_H), (size_t)MT * D); return; }
    if (RUNPH(2)) { ENV();
#pragma unroll 1
      for (int L = c; L < 130 * 10; L += G) {
        int pm, pn; tile_order(L, 130, 10, pm, pn); pm = opq(pm); pn = opq(pn);
        bf16_t* dst; unsigned ld; int ncols = 256, act = 0;
        if (pn < 2) { dst = ACT + A_ZPOOL + (size_t)pm * 256 * 512 + pn * 256; ld = 512; }
        else if (pn < 4) { dst = ACT + A_ZQ + (size_t)pm * 256 * 512 + (pn - 2) * 256; ld = 512; }
        else if (pn == 4) { dst = ACT + A_ZKV + (size_t)pm * 256 * 256; ld = 256; }
        else if (pn == 5) { dst = ACT + A_ZKR + (size_t)pm * 256 * 64; ld = 64; ncols = 64; }
        else if (pn < 8) { dst = ACT + A_U + (size_t)pm * 256 * 512 + (pn - 6) * 256; ld = 512; act = 1; }
        else { dst = ACT + A_VG + (size_t)pm * 256 * 512 + (pn - 8) * 256; ld = 512; act = 1; }
        const bf16_t* Ap = H + (size_t)pm * 256 * D; const bf16_t* Bp = WB + W_SM + (size_t)pn * 256 * D;
        if (act) gemm_tile(Ap, D, Bp, D, D, lds3, EpiBf16<1>{dst, ld, ncols});
        else gemm_tile(Ap, D, Bp, D, D, lds3, EpiBf16<0>{dst, ld, ncols});
      } }
    GSYNC();
    DBG(1, A_ZQ, (size_t)MT * 512)
    if (RUNPH(3)) { const P p = load_params<M_WS | (1u << 10) | (1u << 12) | (1u << 16)>(); phase_prep(p, layer, smem); }
    GSYNC();
    if (RUNPH(4)) { ENV();
#pragma unroll 1
      for (int L = c; L < nMr * 6; L += G) {
        int pm, pn; tile_order(L, nMr, 6, pm, pn); pm = opq(pm); pn = opq(pn);
        gemm_tile(ACT + A_ZQ + (size_t)pm * 256 * 512, 512, WB + W_UQ + (size_t)pn * 256 * 512, 512, 512, lds3, EpiBf16<0>{ACT + A_Q + (size_t)pm * 256 * 1536 + pn * 256, 1536, 256});
      }
#pragma unroll 1
      for (int L = c; L < 130 * 8; L += G) {
        int pm, pn; tile_order(L, 130, 8, pm, pn); pm = opq(pm); pn = opq(pn);
        const size_t kr = kv_row(pm * 256);
        gemm_tile(ACT + A_ZKV + (size_t)pm * 256 * 256, 256, WB + W_UKV + (size_t)pn * 256 * 256, 256, 256, lds3, EpiKV{ACT + A_K + kr * 1536 + pn * 192, ACT + A_V + kr * 1024 + pn * 128});
      } }
    if (RUNPH(5)) { const P p = load_params<M_WS | (1u << 9) | (1u << 18)>(); phase_small(p, layer); }
    GSYNC();
    if (RUNPH(6)) { const P p = load_params<M_WS | (1u << 14) | (1u << 15)>(); phase_qk(p, layer); }
    GSYNC();
    DBG(2, A_K, (size_t)MT * 1536)
    if (DBG_STOP == 7 && layer == 0) { const bf16_t* a = (const bf16_t*)(load_params<M_WS>().ws + OFF_ACT); dbg_dump(a + A_ZPOOL, (size_t)MT * 512, a + A_U, (size_t)MT * 512); return; }
    if (RUNPH(7)) { const P p = load_params<M_WS>(); phase_attn(p, layer, smem); }
    GSYNC();
    DBG(3, A_ATT, (size_t)MT * 1024)
    if (RUNPH(8)) { const int G0 = ogrid(), c0 = obid();
#define MENV() ENV(); const int pm_ = opq(pm), pn_ = opq(pn); \
          unsigned char* s0 = p.ws + OFF_GS + (size_t)c * 131072; unsigned char* s1 = p.ws + OFF_YS + (size_t)c * 262144; unsigned char* s2 = s1 + 131072; \
          bf16_t* yp = ACT + A_Y + (size_t)pm_ * 256 * D + pn_ * 256; const bf16_t* gA = H + (size_t)pm_ * 256 * D; (void)yp; (void)gA; (void)s0; (void)s2;
#pragma unroll 1
      for (int L = c0; L < nMr * 8; L += G0) {
        int pm, pn; tile_order(L, nMr, 8, pm, pn);
        { MENV(); gemm_tile(gA, D, WB + W_G + (size_t)(0 * 2048 + pn_ * 256) * D, D, D, lds3, EpiGateR<0, false>{s0, s1, s2, 15}); }
        { MENV(); gemm_tile(gA, D, WB + W_G + (size_t)(1 * 2048 + pn_ * 256) * D, D, D, lds3, EpiGateR<1, false>{s0, s1, s2, 15}); }
        { MENV(); gemm_tile(gA, D, WB + W_G + (size_t)(2 * 2048 + pn_ * 256) * D, D, D, lds3, EpiGateR<2, false>{s0, s1, s2, 15}); }
        { Acc acc;
          { MENV(); gemm_tile_acc<true, false>(ACT + A_ZPOOL + (size_t)pm_ * 256 * 512, 512, WB + W_BP + (size_t)pn_ * 256 * 512, 512, 512, lds3, acc, EpiScale<false, false>{s0, yp, 15}); }
          { MENV(); gemm_tile_acc<false, false>(ACT + A_ATT + (size_t)pm_ * 256 * 1024, 1024, WB + W_BM + (size_t)pn_ * 256 * 1024, 1024, 1024, lds3, acc, EpiScale<false, false>{s1, yp, 15}); }
          { MENV(); gemm_tile_acc<false, false>(ACT + A_U + (size_t)pm_ * 256 * 512, 512, WB + W_BS + (size_t)pn_ * 256 * 512, 512, 512, lds3, acc, EpiScale<true, false>{s2, yp, 15}); } }
      }
#undef MENV
    }
    GSYNC();
    DBG(4, A_Y, (size_t)NLAT * D)
    if (RUNPH(9)) { ENV(); const int nFull = 128 * 8, nUnits = nFull + (layer == 0 ? 64 : 0);
#pragma unroll 1
      for (int L = c; L < nUnits; L += G) {
        int pm, pn, qmk = 15;
        if (L < nFull) tile_order(L, 128, 8, pm, pn); else { const int t = (L - nFull) >> 2; pm = 128 + (t >> 3); pn = t & 7; qmk = 1 << ((L - nFull) & 3); }
        pm = opq(pm); pn = opq(pn); qmk = opq(qmk);
        const int r0 = pm * 256; const float* gate = modl + mod_row(r0) * 12288 + 2 * 2048 + pn * 256;
        const float* xin = (r0 < NLAT ? xlat + (size_t)r0 * D : xctx + (size_t)(r0 - NLAT) * D) + pn * 256;
        float* xo = (r0 < NLAT ? p.out + (size_t)r0 * D : XC + (size_t)(r0 - NLAT) * D) + pn * 256;
        Acc acc;
        if (L < nFull) gemm_tile_acc<true, false>(ACT + A_Y + (size_t)r0 * D, D, WB + W_O + (size_t)pn * 256 * D, D, D, lds3, acc, EpiRes<false>{xin, xo, gate, 15});
        else gemm_tile_acc<true, true>(ACT + A_Y + (size_t)r0 * D, D, WB + W_O + (size_t)pn * 256 * D, D, D, lds3, acc, EpiRes<true>{xin, xo, gate, qmk}, qmk);
      } }
    GSYNC();
    if (DBG_STOP == 5 && layer == 0) return;
    if (RUNPH(1)) { ENV(); phase_norm(p.out, XC, p.norm2_g + layer * D, modl, 3, 4, H, true, layer == 0 ? MT : NLAT); }
    GSYNC();
    if (RUNPH(10)) { ENV(); const int nMf = layer == 0 ? 133 : 130;
#pragma unroll 1
      for (int L = c; L < nMf * 44; L += G) {
        int pm, pn; tile_order(L, nMf, 44, pm, pn); pm = opq(pm); pn = opq(pn);
        size_t hrow, frow; int nvalid, hole = 100000;
        if (pm < 130) { const int b = pm / 65, i = pm % 65; hrow = (size_t)b * HP_LAT + i * 254; frow = (size_t)b * SEQ + i * 254; nvalid = min(254, SEQ - i * 254); }
        else { const int i = pm - 130; hrow = (size_t)HP_CTX0 + i * 254; frow = (size_t)NLAT + i * 254; nvalid = i == 2 ? 6 : 254; hole = i == 0 ? 100000 : (i == 1 ? 3 : -2); }
        gemm_tile(H + hrow * D, D, WB + W_UP + (size_t)pn * 256 * D, D, D, lds3,
                  EpiConv{lds3, p.ffn_conv_w + (size_t)layer * 3 * F2, p.ffn_conv_b + (size_t)layer * F2, ACT + A_F + frow * DFF, pn * 128, nvalid, hole});
      } }
    GSYNC();
    DBG(6, A_F, (size_t)NLAT * D)
    if (RUNPH(11)) { ENV(); const int nFull = 128 * 8, nUnits = nFull + (layer == 0 ? 64 : 0);
#pragma unroll 1
      for (int L = c; L < nUnits; L += G) {
        int pm, pn, qmk = 15;
        if (L < nFull) tile_order(L, 128, 8, pm, pn); else { const int t = (L - nFull) >> 2; pm = 128 + (t >> 3); pn = t & 7; qmk = 1 << ((L - nFull) & 3); }
        pm = opq(pm); pn = opq(pn); qmk = opq(qmk);
        const int r0 = pm * 256; const float* gate = modl + mod_row(r0) * 12288 + 5 * 2048 + pn * 256;
        float* xo = (r0 < NLAT ? p.out + (size_t)r0 * D : XC + (size_t)(r0 - NLAT) * D) + pn * 256;
        Acc acc;
        if (L < nFull) gemm_tile_acc<true, false>(ACT + A_F + (size_t)r0 * DFF, DFF, WB + W_DN + (size_t)pn * 256 * DFF, DFF, DFF, lds3, acc, EpiRes<false>{xo, xo, gate, 15});
        else gemm_tile_acc<true, true>(ACT + A_F + (size_t)r0 * DFF, DFF, WB + W_DN + (size_t)pn * 256 * DFF, DFF, DFF, lds3, acc, EpiRes<true>{xo, xo, gate, qmk}, qmk);
      } }
    if (layer == 0) GSYNC();
  }
}

extern "C" void kernel_launch(void* const* d_in, const int* in_sizes, int n_in, void* d_out, int out_size, void* d_ws, size_t ws_size, hipStream_t stream) {
  static int grid_blocks = 0;
  if (grid_blocks == 0) {
    if (n_in != 28 || ws_size < WS_NEED) { fprintf(stderr, "kernel_launch: n_in %d ws %zu (need %zu)\n", n_in, ws_size, (size_t)WS_NEED); grid_blocks = -1; return; }
    int dev = 0, cus = 0, per_cu = 0;
    hipGetDevice(&dev);
    hipDeviceGetAttribute(&cus, hipDeviceAttributeMultiprocessorCount, dev);
    if (hipFuncSetAttribute((const void*)mega, hipFuncAttributeMaxDynamicSharedMemorySize, LDS_BYTES) != hipSuccess) { fprintf(stderr, "kernel_launch: LDS attribute failed\n"); grid_blocks = -1; return; }
    hipOccupancyMaxActiveBlocksPerMultiprocessor(&per_cu, (const void*)mega, NTHR, LDS_BYTES);
    if (per_cu < 1) { fprintf(stderr, "kernel_launch: occupancy query %d\n", per_cu); per_cu = 1; }
    (void)hipGetLastError();
    grid_blocks = cus;
    if (grid_blocks > 256) grid_blocks = 256;
  }
  if (grid_blocks < 0) return;
  hipMemsetAsync((char*)d_ws + OFF_CTL, 0, 4096, stream);
  P p{};
  const float** pp = (const float**)&p;
  for (int i = 0; i < 28; ++i) pp[i] = (const float*)d_in[i];
  p.out = (float*)d_out; p.ws = (unsigned char*)d_ws;
  void* args[] = {&p};
  hipError_t e = hipLaunchCooperativeKernel((const void*)mega, dim3(grid_blocks), dim3(NTHR), args, LDS_BYTES, stream);
  if (e != hipSuccess) fprintf(stderr, "cooperative launch failed: %s (grid %d)\n", hipGetErrorString(e), grid_blocks);
}
```

```cpp
#include <hip/hip_runtime.h>
#include <hip/hip_cooperative_groups.h>
#include <cstdio>
#include <cstdint>
namespace cg = cooperative_groups;

typedef unsigned short bf16_t;
typedef short bf16x8 __attribute__((ext_vector_type(8)));
typedef short s16x4 __attribute__((ext_vector_type(4)));
typedef float f32x4 __attribute__((ext_vector_type(4)));
typedef float f32x16 __attribute__((ext_vector_type(16)));
typedef unsigned u32x4 __attribute__((ext_vector_type(4)));
typedef unsigned u32x2 __attribute__((ext_vector_type(2)));
#define LAS __attribute__((address_space(3)))

constexpr int D = 2048, NB = 2, SEQ = 16384, CTX = 256, NLAT = NB * SEQ, NCTX = NB * CTX, MT = NLAT + NCTX;
constexpr int INC = 8512, F2 = 11264, DFF = 5632, KVS = SEQ + CTX;
constexpr int NTHR = 512;
constexpr float EPS = 1e-6f;
constexpr int HROWS = 33600;
constexpr int HP_LAT = SEQ + 2, HP_CTX0 = 2 * HP_LAT, HP_CTX = CTX + 2;

constexpr size_t al256(size_t x) { return (x + 255) & ~(size_t)255; }
constexpr size_t OFF_CTL = 0;
constexpr size_t OFF_MOD = 4096;
constexpr size_t OFF_XC = al256(OFF_MOD + 2 * 3 * 12288 * 4);
constexpr size_t OFF_WB = al256(OFF_XC + (size_t)NCTX * D * 4);
constexpr size_t W_SM = 0;
constexpr size_t W_G = W_SM + (size_t)2560 * 2048;
constexpr size_t W_UQ = W_G + (size_t)6144 * 2048;
constexpr size_t W_UKV = W_UQ + (size_t)1536 * 512;
constexpr size_t W_POOL = W_UKV + (size_t)2048 * 256;
constexpr size_t W_SG = W_POOL + 65536;
constexpr size_t W_BP = W_SG + 65536;
constexpr size_t W_BM = W_BP + (size_t)2048 * 512;
constexpr size_t W_BS = W_BM + (size_t)2048 * 1024;
constexpr size_t W_O = W_BS + (size_t)2048 * 512;
constexpr size_t W_UP = W_O + (size_t)2048 * 2048;
constexpr size_t W_DN = W_UP + (size_t)F2 * 2048;
constexpr size_t W_END = W_DN + (size_t)2048 * DFF;
constexpr size_t OFF_H = al256(OFF_WB + W_END * 2);
constexpr size_t OFF_GS = al256(OFF_H + (size_t)HROWS * D * 2);
constexpr size_t OFF_YS = al256(OFF_GS + (size_t)256 * 131072);
constexpr size_t OFF_ACT = al256(OFF_YS + (size_t)256 * 262144);
constexpr size_t A_ZPOOL = 0;
constexpr size_t A_POOLED = A_ZPOOL + (size_t)MT * 512;
constexpr size_t A_ZQ = A_POOLED + (size_t)MT * 512;
constexpr size_t A_ZKV = A_ZQ + (size_t)MT * 512;
constexpr size_t A_ZKR = A_ZKV + (size_t)MT * 256;
constexpr size_t A_U = A_ZKR + (size_t)MT * 64;
constexpr size_t A_VG = A_U + (size_t)MT * 512;
constexpr size_t A_Q = A_VG + (size_t)MT * 512;
constexpr size_t A_K = A_Q + (size_t)MT * 1536;
constexpr size_t A_V = A_K + (size_t)MT * 1536;
constexpr size_t A_ATT = A_V + (size_t)MT * 1024;
constexpr size_t A_END = A_ATT + (size_t)MT * 1024;
constexpr size_t A_Y = A_END;
constexpr size_t A_F = 0;
static_assert((size_t)MT * DFF <= A_END, "f fits");
constexpr size_t WS_NEED = OFF_ACT + (A_END + (size_t)MT * 2048) * 2;
static_assert(WS_NEED <= ((size_t)1 << 30), "workspace plan must fit 1 GiB");

constexpr int LDS_BYTES = 139264;

struct P {
  const float *x, *c, *ctx, *c_ctx, *ada_w, *ada_b, *norm1_g, *w_in, *pool_w, *pool_scale, *q_lat_g, *w_uq, *kv_lat_g, *w_ukv, *q_norm_g, *k_norm_g,
      *sg_norm_g, *sg_w, *sg_b, *w_br_pool, *w_br_mla, *w_br_sg, *w_o, *norm2_g, *ffn_up, *ffn_conv_w, *ffn_conv_b, *ffn_down;
  float* out; unsigned char* ws;
};

typedef __bf16 bf16v2 __attribute__((ext_vector_type(2)));
typedef float f32x2 __attribute__((ext_vector_type(2)));
__device__ __forceinline__ unsigned cvtpk(float lo, float hi) { f32x2 v = {lo, hi}; bf16v2 b = __builtin_convertvector(v, bf16v2); return __builtin_bit_cast(unsigned, b); }
__device__ __forceinline__ float bflo(unsigned u) { return __uint_as_float(u << 16); }
__device__ __forceinline__ float bfhi(unsigned u) { return __uint_as_float(u & 0xffff0000u); }
__device__ __forceinline__ float wave_sum(float v) {
#pragma unroll
  for (int o = 32; o > 0; o >>= 1) v += __shfl_xor(v, o);
  return v;
}
__device__ __forceinline__ int otid() { int t = threadIdx.x; asm volatile("" : "+v"(t)); return t; }
__device__ __forceinline__ int obid() { int t = blockIdx.x; asm volatile("" : "+s"(t)); return t; }
__device__ __forceinline__ int ogrid() { int t = gridDim.x; asm volatile("" : "+s"(t)); return t; }
__device__ __forceinline__ float sigmoidf_(float x) { return __builtin_amdgcn_rcpf(1.f + __expf(-x)); }
__device__ __forceinline__ float gelu_tanh(float x) { const float u = 1.5957691216057308f * (x + 0.044715f * x * x * x); return x * __builtin_amdgcn_rcpf(1.f + __expf(-u)); }
__device__ __forceinline__ void unpack8(u32x4 w, float* f) {
  f[0] = bflo(w.x); f[1] = bfhi(w.x); f[2] = bflo(w.y); f[3] = bfhi(w.y); f[4] = bflo(w.z); f[5] = bfhi(w.z); f[6] = bflo(w.w); f[7] = bfhi(w.w);
}
__device__ __forceinline__ u32x4 pack8(const float* f) { u32x4 w; w.x = cvtpk(f[0], f[1]); w.y = cvtpk(f[2], f[3]); w.z = cvtpk(f[4], f[5]); w.w = cvtpk(f[6], f[7]); return w; }

__device__ __forceinline__ void grid_barrier(unsigned* ctr, unsigned target) {
  asm volatile("s_waitcnt vmcnt(0) lgkmcnt(0)" ::: "memory");
  __syncthreads();
  if (threadIdx.x == 0) {
    __builtin_amdgcn_fence(__ATOMIC_RELEASE, "agent");
    asm volatile("s_waitcnt vmcnt(0)" ::: "memory");
    __hip_atomic_fetch_add(ctr, 1u, __ATOMIC_RELAXED, __HIP_MEMORY_SCOPE_AGENT);
    while (__hip_atomic_load(ctr, __ATOMIC_RELAXED, __HIP_MEMORY_SCOPE_AGENT) < target) __builtin_amdgcn_s_sleep(2);
    __builtin_amdgcn_fence(__ATOMIC_ACQUIRE, "agent");
    asm volatile("s_waitcnt vmcnt(0)" ::: "memory");
  }
  __syncthreads();
}

__device__ __forceinline__ int kv_row(int r) { return r < NLAT ? (r >> 14) * KVS + (r & (SEQ - 1)) : ((r - NLAT) >> 8) * KVS + SEQ + ((r - NLAT) & 255); }
__device__ __forceinline__ int mod_row(int r) { return r < NLAT ? (r >> 14) : 2; }

__device__ __forceinline__ void tile_order(int L, int nM, int nN, int& pm, int& pn) {
  const int nwg = nM * nN; int wgid = L;
  { const int q = nwg / 8, r = nwg % 8, xcd = wgid % 8, off = wgid / 8; wgid = (xcd < r ? xcd * (q + 1) : r * (q + 1) + (xcd - r) * q) + off; }
  const int nig = 2 * nN, gid = wgid / nig, fm = gid * 2, gsz = (nM - fm) < 2 ? (nM - fm) : 2;
  pm = fm + ((wgid % nig) % gsz); pn = (wgid % nig) / gsz;
}

__device__ __forceinline__ int lds_byte(int r, int c) { int st = (r >> 4) * 2 + (c >> 5), rr = r & 15, cc = c & 31, ob = rr * 64 + cc * 2; return st * 1024 + (ob ^ (((ob >> 9) & 1) << 5)); }
__device__ __forceinline__ void stage_rc(int b, int& R, int& C) { int st = b / 1024, sb = b % 1024, swz = sb ^ (((sb >> 9) & 1) << 5); R = (st >> 1) * 16 + swz / 64; C = (st & 1) * 32 + (swz % 64) / 2; }
#define GL_LDS(gp, lp) __builtin_amdgcn_global_load_lds((const __attribute__((address_space(1))) unsigned*)(gp), (__attribute__((address_space(3))) unsigned*)(lp), 16, 0, 0)

typedef f32x4 Acc[2][2][4][2];
#define QON(ai_, bj_) (!PART || ((qm >> ((ai_) * 2 + (bj_))) & 1))
template <bool ZERO, bool PART, class Epi>
__device__ __forceinline__ void gemm_tile_acc(const bf16_t* A, unsigned lda, const bf16_t* Bt, unsigned ldb, int K, LAS unsigned char* lds, Acc& acc, const Epi& epi, int qm = 15) {
  int tid = threadIdx.x; asm volatile("" : "+v"(tid));
  const int wid = __builtin_amdgcn_readfirstlane(tid >> 6), lane = tid & 63, wr = wid >> 2, wc = wid & 3, fr = lane & 15, fq = lane >> 4;
  unsigned voffA[2], voffB[2];
#pragma unroll
  for (int i = 0; i < 2; ++i) { int R, C; stage_rc(tid * 16 + i * 8192, R, C); voffA[i] = (unsigned)(R * lda + C) * 2u; voffB[i] = (unsigned)(R * ldb + C) * 2u; }
  const unsigned ldsw = (unsigned)wid * 1024u;
  const int aoff = lds_byte(wr * 64 + fr, fq * 8), boff = lds_byte(wc * 32 + fr, fq * 8);
  const char* cA = (const char*)A; const char* cB = (const char*)Bt;
  const size_t hA = (size_t)128 * lda * 2, hB = (size_t)128 * ldb * 2;
#define SAo(b, h) (((b) * 2 + (h)) * 16384)
#define SBo(b, h) ((4 + (b) * 2 + (h)) * 16384)
#define STG(bufoff, gbase, voff) do { _Pragma("unroll") for (int _i = 0; _i < 2; ++_i) \
    __builtin_amdgcn_global_load_lds((const unsigned*)((const char*)(gbase) + (voff)[_i]), (LAS unsigned*)(lds + (bufoff) + ldsw + _i * 8192), 16, 0, 0); } while (0)
#define STA(b, h, kt) STG(SAo(b, h), cA + (h) * hA + (size_t)(kt) * 128, voffA)
#define STB(b, h, kt) STG(SBo(b, h), cB + (h) * hB + (size_t)(kt) * 128, voffB)
#define LDA(dst, b, h) do { _Pragma("unroll") for (int m = 0; m < 4; ++m) _Pragma("unroll") for (int k = 0; k < 2; ++k) dst[m][k] = *(const LAS bf16x8*)(lds + SAo(b, h) + aoff + m * 2048 + k * 1024); } while (0)
#define LDB(dst, b, h) do { _Pragma("unroll") for (int n = 0; n < 2; ++n) _Pragma("unroll") for (int k = 0; k < 2; ++k) dst[n][k] = *(const LAS bf16x8*)(lds + SBo(b, h) + boff + n * 2048 + k * 1024); } while (0)
#define MMA(ai, bj, At_, Bt_) do { __builtin_amdgcn_s_setprio(1); \
    _Pragma("unroll") for (int m = 0; m < 4; ++m) _Pragma("unroll") for (int n = 0; n < 2; ++n) _Pragma("unroll") for (int k = 0; k < 2; ++k) \
      acc[ai][bj][m][n] = __builtin_amdgcn_mfma_f32_16x16x32_bf16(Bt_[n][k], At_[m][k], acc[ai][bj][m][n], 0, 0, 0); \
    __builtin_amdgcn_s_setprio(0); } while (0)
#define WAIT_V(n) asm volatile("s_waitcnt vmcnt(" #n ")" ::: "memory")
#define WAIT_L(n) asm volatile("s_waitcnt lgkmcnt(" #n ")" ::: "memory")
#define BAR __builtin_amdgcn_s_barrier()
#define SCHED __builtin_amdgcn_sched_barrier(0)
  if (ZERO) {
  float z0 = 0.f; asm volatile("" : "+v"(z0));
#pragma unroll
  for (int a = 0; a < 2; ++a)
#pragma unroll
    for (int b = 0; b < 2; ++b)
#pragma unroll
      for (int m = 0; m < 4; ++m)
#pragma unroll
        for (int n = 0; n < 2; ++n) acc[a][b][m][n] = (f32x4){z0, z0, z0, z0};
  }
#define MMQ(ai, bj, At_, Bt_) do { if (!PART || ((qm >> ((ai) * 2 + (bj))) & 1)) MMA(ai, bj, At_, Bt_); } while (0)
  bf16x8 At[4][2], B0[2][2], B1[2][2];
  const int nt = K / 64;
  STB(0, 0, 0); STB(0, 1, 0); STA(0, 0, 0); STA(0, 1, 0);
  if (wr == 1) BAR;
  WAIT_V(2); BAR;
  STB(1, 0, 1); STA(1, 0, 1); STB(1, 1, 1);
  WAIT_V(6); BAR;
  for (int t = 0; t < nt; t += 2) {
    const int k2 = (t == nt - 2) ? 0 : t + 2;
    LDB(B0, 0, 0); LDB(B1, 0, 1); SCHED; LDA(At, 0, 0); STA(1, 1, t + 1);
    WAIT_V(8); WAIT_L(0); BAR; MMQ(0, 0, At, B0); MMQ(0, 1, At, B1); BAR; SCHED;
    LDA(At, 0, 1); STB(0, 0, k2); STB(0, 1, k2); STA(0, 0, k2);
    WAIT_V(8); WAIT_L(0); BAR; MMQ(1, 0, At, B0); MMQ(1, 1, At, B1); BAR; SCHED;
    LDB(B0, 1, 0); LDB(B1, 1, 1); SCHED; LDA(At, 1, 0); STA(0, 1, k2);
    WAIT_V(8); WAIT_L(0); BAR; MMQ(0, 0, At, B0); MMQ(0, 1, At, B1); BAR; SCHED;
    LDA(At, 1, 1); STB(1, 0, k2 + 1); STB(1, 1, k2 + 1); STA(1, 0, k2 + 1);
    WAIT_V(8); WAIT_L(0); BAR; MMQ(1, 0, At, B0); MMQ(1, 1, At, B1); BAR; SCHED;
  }
  WAIT_V(0);
  if (wr == 0) BAR;
  BAR;
  epi(acc, wr, wc, fr, fq);
}
template <class Epi>
__device__ __forceinline__ void gemm_tile(const bf16_t* A, unsigned lda, const bf16_t* Bt, unsigned ldb, int K, LAS unsigned char* lds, const Epi& epi) {
  Acc acc; gemm_tile_acc<true, false>(A, lda, Bt, ldb, K, lds, acc, epi);
}

template <int ACT> struct EpiBf16 {
  bf16_t* dst; unsigned ld; int ncols;
  __device__ __forceinline__ void operator()(Acc& acc, int wr, int wc, int fr, int fq) const {
    bf16_t* d0 = dst + (size_t)(wr * 64) * ld + wc * 32; const unsigned lo = (unsigned)(fr * ld + 4 * fq) * 2u;
#pragma unroll
    for (int ai = 0; ai < 2; ++ai)
#pragma unroll
      for (int m = 0; m < 4; ++m) {
#pragma unroll
        for (int bj = 0; bj < 2; ++bj)
#pragma unroll
          for (int n = 0; n < 2; ++n) {
            f32x4 v = acc[ai][bj][m][n];
            if (ACT == 1) { v[0] = gelu_tanh(v[0]); v[1] = gelu_tanh(v[1]); v[2] = gelu_tanh(v[2]); v[3] = gelu_tanh(v[3]); }
            if (bj * 128 + wc * 32 + n * 16 < ncols) { u32x2 w; w.x = cvtpk(v[0], v[1]); w.y = cvtpk(v[2], v[3]);
              *(u32x2*)((unsigned char*)(d0 + (size_t)(ai * 128 + m * 16) * ld + bj * 128 + n * 16) + lo) = w; }
          }
      }
  }
};
struct EpiKV {
  bf16_t* kd; bf16_t* vd;
  __device__ __forceinline__ void operator()(Acc& acc, int wr, int wc, int fr, int fq) const {
    bf16_t* k0 = kd + (size_t)(wr * 64) * 1536 + wc * 32; bf16_t* v0 = vd + (size_t)(wr * 64) * 1024 + wc * 32;
    const unsigned lk = (unsigned)(fr * 1536 + 4 * fq) * 2u, lv = (unsigned)(fr * 1024 + 4 * fq) * 2u;
#pragma unroll
    for (int ai = 0; ai < 2; ++ai)
#pragma unroll
      for (int m = 0; m < 4; ++m) {
#pragma unroll
        for (int n = 0; n < 2; ++n) {
          const f32x4 a = acc[ai][0][m][n], b = acc[ai][1][m][n];
          u32x2 w; w.x = cvtpk(a[0], a[1]); w.y = cvtpk(a[2], a[3]); *(u32x2*)((unsigned char*)(k0 + (size_t)(ai * 128 + m * 16) * 1536 + n * 16) + lk) = w;
          w.x = cvtpk(b[0], b[1]); w.y = cvtpk(b[2], b[3]); *(u32x2*)((unsigned char*)(v0 + (size_t)(ai * 128 + m * 16) * 1024 + n * 16) + lv) = w;
        }
      }
  }
};
template <bool PART> struct EpiRes {
  const float* xin; float* xout; const float* gate; int qm;
  __device__ __forceinline__ void operator()(Acc& acc, int wr, int wc, int fr, int fq) const {
    const float* g0 = gate + wc * 32 + 4 * fq;
    const float* xi0 = xin + (size_t)(wr * 64) * D + wc * 32; float* xo0 = xout + (size_t)(wr * 64) * D + wc * 32;
    const unsigned lo = (unsigned)(fr * D + 4 * fq) * 4u;
    f32x4 xa[2][2], xb[2][2], xc[2][2];
#define RES_LD(buf, gi) _Pragma("unroll") for (int bj = 0; bj < 2; ++bj) if (QON((gi) >> 2, bj)) _Pragma("unroll") for (int n = 0; n < 2; ++n) \
      buf[bj][n] = *(const f32x4*)((const char*)(xi0 + (size_t)(((gi) >> 2) * 128 + ((gi) & 3) * 16) * D + bj * 128 + n * 16) + lo)
#define RES_ST(buf, gi) _Pragma("unroll") for (int bj = 0; bj < 2; ++bj) if (QON((gi) >> 2, bj)) _Pragma("unroll") for (int n = 0; n < 2; ++n) \
      *(f32x4*)((char*)(xo0 + (size_t)(((gi) >> 2) * 128 + ((gi) & 3) * 16) * D + bj * 128 + n * 16) + lo) = buf[bj][n] + *(const f32x4*)(g0 + bj * 128 + n * 16) * acc[(gi) >> 2][bj][(gi) & 3][n]
    RES_LD(xa, 0); RES_LD(xb, 1); RES_LD(xc, 2);
    RES_ST(xa, 0); RES_LD(xa, 3);
    RES_ST(xb, 1); RES_LD(xb, 4);
    RES_ST(xc, 2); RES_LD(xc, 5);
    RES_ST(xa, 3); RES_LD(xa, 6);
    RES_ST(xb, 4); RES_LD(xb, 7);
    RES_ST(xc, 5);
    RES_ST(xa, 6);
    RES_ST(xb, 7);
#undef RES_LD
#undef RES_ST
  }
};
template <int BR, bool PART> struct EpiGateR {
  unsigned char* s0; unsigned char* s1; unsigned char* s2; int qm;
  __device__ __forceinline__ void operator()(Acc& acc, int wr, int wc, int fr, int fq) const {
    const unsigned wo = (unsigned)(wr * 4 + wc) * 16384u, lo = (unsigned)(fq * 16 + fr) * 8u;
    unsigned char* cur = (BR == 0 ? s0 : BR == 1 ? s1 : s2) + wo; unsigned char* prv = (BR == 1 ? s0 : s1) + wo;
#pragma unroll
    for (int hf = 0; hf < 4; ++hf) {
      u32x2 pw[8];
      if (BR != 0) {
#pragma unroll
        for (int q = 0; q < 8; ++q) if (QON((hf * 8 + q) >> 4, ((hf * 8 + q) >> 1) & 1)) pw[q] = *(const u32x2*)(prv + (hf * 8 + q) * 512 + lo);
      }
#pragma unroll
      for (int q = 0; q < 8; ++q) {
        const int s = hf * 8 + q, ai = s >> 4, m = (s >> 2) & 3, bj = (s >> 1) & 1, n = s & 1;
        if (!QON(ai, bj)) continue;
        const f32x4 z = acc[ai][bj][m][n]; f32x4 inv, g;
#pragma unroll
        for (int e = 0; e < 4; ++e) { inv[e] = 1.f + __expf(-fminf(fmaxf(z[e], -30.f), 30.f)); g[e] = __builtin_amdgcn_rcpf(inv[e]); }
        u32x2 w; w.x = cvtpk(g[0], g[1]); w.y = cvtpk(g[2], g[3]);
        *(u32x2*)(cur + s * 512 + lo) = w;
        if (BR != 0) { f32x4 r; r[0] = bflo(pw[q].x) * inv[0]; r[1] = bfhi(pw[q].x) * inv[1]; r[2] = bflo(pw[q].y) * inv[2]; r[3] = bfhi(pw[q].y) * inv[3];
          u32x2 o; o.x = cvtpk(r[0], r[1]); o.y = cvtpk(r[2], r[3]); *(u32x2*)(prv + s * 512 + lo) = o; }
      }
    }
  }
};
template <bool LAST, bool PART> struct EpiScale {
  const unsigned char* sl; bf16_t* y; int qm;
  __device__ __forceinline__ void operator()(Acc& acc, int wr, int wc, int fr, int fq) const {
    const unsigned char* wb = sl + (wr * 4 + wc) * 16384; const unsigned lo = (unsigned)(fq * 16 + fr) * 8u;
    bf16_t* yw = y + (size_t)(wr * 64) * D + wc * 32; const unsigned yo = (unsigned)(fr * D + 4 * fq) * 2u;
#pragma unroll
    for (int hf = 0; hf < 4; ++hf) {
      u32x2 pw[8];
#pragma unroll
      for (int q = 0; q < 8; ++q) if (QON((hf * 8 + q) >> 4, ((hf * 8 + q) >> 1) & 1)) pw[q] = *(const u32x2*)(wb + (hf * 8 + q) * 512 + lo);
#pragma unroll
      for (int q = 0; q < 8; ++q) {
        const int s = hf * 8 + q, ai = s >> 4, m = (s >> 2) & 3, bj = (s >> 1) & 1, n = s & 1;
        if (!QON(ai, bj)) continue;
        f32x4 r; r[0] = bflo(pw[q].x); r[1] = bfhi(pw[q].x); r[2] = bflo(pw[q].y); r[3] = bfhi(pw[q].y);
        const f32x4 v = acc[ai][bj][m][n] * r;
        if (!LAST) acc[ai][bj][m][n] = v;
        else { u32x2 o; o.x = cvtpk(v[0], v[1]); o.y = cvtpk(v[2], v[3]);
          *(u32x2*)((unsigned char*)(yw + (size_t)(ai * 128 + m * 16) * D + bj * 128 + n * 16) + yo) = o; }
      }
    }
  }
};
constexpr int CS = 528;
struct EpiConv {
  LAS unsigned char* shm; const float* cw; const float* cb;
  bf16_t* f; int ch0; int nvalid; int hole;
  __device__ __forceinline__ void operator()(Acc& acc, int wr, int wc, int fr, int fq) const {
    int tid = threadIdx.x; asm volatile("" : "+v"(tid)); const int cgp = tid & 15, rg = tid >> 4;
    const int ch = ch0 + cgp * 8;
    float wa[3][8], wv[3][8], ba[8], bv[8];
#pragma unroll
    for (int j = 0; j < 3; ++j)
#pragma unroll
      for (int e = 0; e < 8; e += 4) {
        const f32x4 t0 = *(const f32x4*)(cw + (long)j * F2 + ch + e), t1 = *(const f32x4*)(cw + (long)j * F2 + DFF + ch + e);
        wa[j][e] = t0[0]; wa[j][e + 1] = t0[1]; wa[j][e + 2] = t0[2]; wa[j][e + 3] = t0[3];
        wv[j][e] = t1[0]; wv[j][e + 1] = t1[1]; wv[j][e + 2] = t1[2]; wv[j][e + 3] = t1[3];
      }
#pragma unroll
    for (int e = 0; e < 8; e += 4) {
      const f32x4 t0 = *(const f32x4*)(cb + ch + e), t1 = *(const f32x4*)(cb + DFF + ch + e);
      ba[e] = t0[0]; ba[e + 1] = t0[1]; ba[e + 2] = t0[2]; ba[e + 3] = t0[3];
      bv[e] = t1[0]; bv[e + 1] = t1[1]; bv[e + 2] = t1[2]; bv[e + 3] = t1[3];
    }
#pragma unroll
    for (int ai = 0; ai < 2; ++ai)
#pragma unroll
      for (int m = 0; m < 4; ++m) {
        LAS unsigned char* rp = shm + (ai * 128 + wr * 64 + m * 16 + fr) * CS;
#pragma unroll
        for (int bj = 0; bj < 2; ++bj)
#pragma unroll
          for (int n = 0; n < 2; ++n) {
            const f32x4 v = acc[ai][bj][m][n]; u32x2 w; w.x = cvtpk(v[0], v[1]); w.y = cvtpk(v[2], v[3]);
            *(LAS u32x2*)(rp + (bj * 128 + wc * 32 + n * 16 + 4 * fq) * 2) = w;
          }
      }
    asm volatile("s_waitcnt lgkmcnt(0)" ::: "memory"); __builtin_amdgcn_s_barrier(); asm volatile("" ::: "memory");
    const int R0 = rg * 8;
    float pa[8], ca[8], na[8], pv[8], cv[8], nv[8];
    { const int rp = R0 > 0 ? R0 - 1 : 0;
      unpack8(*(const LAS u32x4*)(shm + rp * CS + cgp * 16), pa); unpack8(*(const LAS u32x4*)(shm + rp * CS + 256 + cgp * 16), pv);
      unpack8(*(const LAS u32x4*)(shm + R0 * CS + cgp * 16), ca); unpack8(*(const LAS u32x4*)(shm + R0 * CS + 256 + cgp * 16), cv); }
#pragma unroll
    for (int i = 0; i < 8; ++i) {
      const int R = R0 + i, rn = R < 255 ? R + 1 : 255;
      unpack8(*(const LAS u32x4*)(shm + rn * CS + cgp * 16), na); unpack8(*(const LAS u32x4*)(shm + rn * CS + 256 + cgp * 16), nv);
      float o[8];
#pragma unroll
      for (int e = 0; e < 8; ++e) {
        const float a = ba[e] + wa[0][e] * pa[e] + wa[1][e] * ca[e] + wa[2][e] * na[e];
        const float v = bv[e] + wv[0][e] * pv[e] + wv[1][e] * cv[e] + wv[2][e] * nv[e];
        o[e] = a * sigmoidf_(a) * v;
      }
      if (R >= 1 && R <= nvalid && !(R >= hole && R < hole + 2)) *(u32x4*)(f + (long)(R - 1 - (R >= hole + 2 ? 2 : 0)) * DFF + ch) = pack8(o);
#pragma unroll
      for (int e = 0; e < 8; ++e) { pa[e] = ca[e]; ca[e] = na[e]; pv[e] = cv[e]; cv[e] = nv[e]; }
    }
    asm volatile("s_waitcnt lgkmcnt(0)" ::: "memory"); __builtin_amdgcn_s_barrier(); asm volatile("" ::: "memory");
  }
};

__device__ __forceinline__ void phase_mod(const P& p, unsigned char* smem) {
  const int tid_ = otid(), bid_ = obid(), grd_ = ogrid(); (void)tid_; (void)bid_; (void)grd_;
  float* s = (float*)smem;
  float* red = s + 3 * 2048;
  const int tid = tid_;
  for (int i = tid; i < 3 * 2048; i += NTHR) { const int r = i >> 11, k = i & 2047; const float v = r < 2 ? p.c[r * 2048 + k] : p.c_ctx[k]; s[i] = v / (1.f + __expf(-v)); }
  __syncthreads();
  float* mod = (float*)(p.ws + OFF_MOD);
  for (int b = bid_; b < 256; b += grd_) {
    const int layer = b >> 7, col0 = (b & 127) * 96, cg4 = tid % 24, ks = tid / 24;
    float a0[4] = {0, 0, 0, 0}, a1[4] = {0, 0, 0, 0}, a2[4] = {0, 0, 0, 0};
    if (ks < 21) {
      const float* wp = p.ada_w + (size_t)layer * 2048 * 12288 + col0 + cg4 * 4;
#pragma unroll 4
      for (int k = ks; k < 2048; k += 21) {
        const f32x4 w = *(const f32x4*)(wp + (size_t)k * 12288);
        const float s0 = s[k], s1 = s[2048 + k], s2 = s[4096 + k];
#pragma unroll
        for (int j = 0; j < 4; ++j) { a0[j] += s0 * w[j]; a1[j] += s1 * w[j]; a2[j] += s2 * w[j]; }
      }
#pragma unroll
      for (int j = 0; j < 4; ++j) { red[(ks * 3 + 0) * 96 + cg4 * 4 + j] = a0[j]; red[(ks * 3 + 1) * 96 + cg4 * 4 + j] = a1[j]; red[(ks * 3 + 2) * 96 + cg4 * 4 + j] = a2[j]; }
    }
    __syncthreads();
    if (tid < 288) {
      const int r = tid / 96, cc = tid % 96; float sum = p.ada_b[layer * 12288 + col0 + cc];
      for (int k = 0; k < 21; ++k) sum += red[(k * 3 + r) * 96 + cc];
      mod[(layer * 3 + r) * 12288 + col0 + cc] = sum;
    }
    __syncthreads();
  }
}

__device__ __forceinline__ void cvt_job(const float* __restrict__ src, int ld_src, int K, int nrows, int colbase, int mode, bf16_t* dst, float* lds, int& rot) {
  const int tid_ = otid(), bid_ = obid(), grd_ = ogrid(); (void)tid_; (void)bid_; (void)grd_;
  const int tid = tid_, ntk = K >> 6, ntiles = (nrows >> 6) * ntk;
  int start = (int)bid_ - rot; if (start < 0) start += grd_;
  for (int t = start; t < ntiles; t += grd_) {
    const int nt = t / ntk, kt = t % ntk, n0 = nt * 64, k0 = kt * 64;
    const int sc0 = mode == 0 ? colbase + n0 : ((n0 >> 8) * 128 + (n0 & 127) + ((n0 >> 7) & 1) * DFF);
    const int kk = tid >> 4, c4 = (tid & 15) * 4;
#pragma unroll
    for (int i = 0; i < 2; ++i) {
      const f32x4 v = *(const f32x4*)(src + (size_t)(k0 + kk + 32 * i) * ld_src + sc0 + c4);
      float* lp = lds + (kk + 32 * i) * 65 + c4; lp[0] = v[0]; lp[1] = v[1]; lp[2] = v[2]; lp[3] = v[3];
    }
    __syncthreads();
    const int n = tid >> 3, kq = (tid & 7) * 8; float f[8];
#pragma unroll
    for (int j = 0; j < 8; ++j) f[j] = lds[(kq + j) * 65 + n];
    *(u32x4*)(dst + (size_t)(n0 + n) * K + k0 + kq) = pack8(f);
    __syncthreads();
  }
  rot = (rot + ntiles) % (int)grd_;
}
__device__ __forceinline__ void phase_cvt(const P& p, int layer, unsigned char* smem) {
  const int tid_ = otid(), bid_ = obid(), grd_ = ogrid(); (void)tid_; (void)bid_; (void)grd_;
  float* lds = (float*)smem; bf16_t* WB = (bf16_t*)(p.ws + OFF_WB); int rot = 0;
  const float* w_in = p.w_in + (size_t)layer * D * INC;
  cvt_job(w_in, INC, D, 1344, 0, 0, WB + W_SM, lds, rot);
  cvt_job(w_in, INC, D, 1024, 1344, 0, WB + W_SM + (size_t)1536 * D, lds, rot);
  cvt_job(w_in, INC, D, 6144, 2368, 0, WB + W_G, lds, rot);
  cvt_job(p.w_uq + (size_t)layer * 512 * 1536, 1536, 512, 1536, 0, 0, WB + W_UQ, lds, rot);
  cvt_job(p.w_ukv + (size_t)layer * 256 * 2048, 2048, 256, 2048, 0, 0, WB + W_UKV, lds, rot);
  for (int g = 0; g < 4; ++g) cvt_job(p.pool_w + ((size_t)layer * 4 + g) * 16384, 128, 128, 128, 0, 0, WB + W_POOL + g * 16384, lds, rot);
  cvt_job(p.w_br_pool + (size_t)layer * 512 * D, D, 512, D, 0, 0, WB + W_BP, lds, rot);
  cvt_job(p.w_br_mla + (size_t)layer * 1024 * D, D, 1024, D, 0, 0, WB + W_BM, lds, rot);
  cvt_job(p.w_br_sg + (size_t)layer * 512 * D, D, 512, D, 0, 0, WB + W_BS, lds, rot);
  cvt_job(p.w_o + (size_t)layer * D * D, D, D, D, 0, 0, WB + W_O, lds, rot);
  cvt_job(p.ffn_up + (size_t)layer * D * F2, F2, D, F2, 0, 1, WB + W_UP, lds, rot);
  cvt_job(p.ffn_down + (size_t)layer * DFF * D, D, DFF, D, 0, 0, WB + W_DN, lds, rot);
  const size_t gt = (size_t)bid_ * NTHR + tid_, gs = (size_t)grd_ * NTHR;
  unsigned zz = 0u; asm volatile("" : "+v"(zz));
  for (size_t i = gt; i < (size_t)192 * D / 8; i += gs) *(u32x4*)(WB + W_SM + (size_t)1344 * D + i * 8) = (u32x4){zz, zz, zz, zz};
  const float* sgw = p.sg_w + (size_t)layer * 65536;
  for (size_t i = gt; i < 65536 / 8; i += gs) { float f[8]; const f32x4 a = *(const f32x4*)(sgw + i * 8), b = *(const f32x4*)(sgw + i * 8 + 4);
    f[0] = a[0]; f[1] = a[1]; f[2] = a[2]; f[3] = a[3]; f[4] = b[0]; f[5] = b[1]; f[6] = b[2]; f[7] = b[3]; *(u32x4*)(WB + W_SG + i * 8) = pack8(f); }
}

__device__ __forceinline__ void phase_norm(const float* xlat, const float* xctx, const float* g, const float* modl, int shc, int scc, bf16_t* H, bool padded, int nrows) {
  const int tid_ = otid(), bid_ = obid(), grd_ = ogrid(); (void)tid_; (void)bid_; (void)grd_;
  const int lane = tid_ & 63, gw = bid_ * 8 + (tid_ >> 6), nw = grd_ * 8;
  for (int r = gw; r < nrows; r += nw) {
    const float* src = r < NLAT ? xlat + (size_t)r * D : xctx + (size_t)(r - NLAT) * D;
    const float* mr = modl + mod_row(r) * 12288;
    float xv[32]; float ss = 0.f;
#pragma unroll
    for (int j = 0; j < 4; ++j) {
      const f32x4 a = *(const f32x4*)(src + j * 512 + lane * 8), b = *(const f32x4*)(src + j * 512 + lane * 8 + 4);
#pragma unroll
      for (int e = 0; e < 4; ++e) { xv[j * 8 + e] = a[e]; xv[j * 8 + 4 + e] = b[e]; ss += a[e] * a[e] + b[e] * b[e]; }
    }
    ss = wave_sum(ss);
    const float rr = rsqrtf(ss * (1.f / D) + EPS);
    size_t drow;
    if (!padded) drow = r;
    else drow = r < NLAT ? (size_t)(r >> 14) * HP_LAT + 1 + (r & (SEQ - 1)) : (size_t)HP_CTX0 + ((r - NLAT) >> 8) * HP_CTX + 1 + ((r - NLAT) & 255);
#pragma unroll
    for (int j = 0; j < 4; ++j) {
      const int c = j * 512 + lane * 8; float o[8];
#pragma unroll
      for (int e = 0; e < 8; e += 4) {
        const f32x4 gg = *(const f32x4*)(g + c + e), sh = *(const f32x4*)(mr + shc * 2048 + c + e), sc = *(const f32x4*)(mr + scc * 2048 + c + e);
#pragma unroll
        for (int q = 0; q < 4; ++q) o[e + q] = xv[j * 8 + e + q] * rr * gg[q] * (1.f + sc[q]) + sh[q];
      }
      *(u32x4*)(H + drow * D + c) = pack8(o);
    }
  }
  if (padded && bid_ == 0) {
    const int tid = tid_;
    for (int i = tid; i < 8 * (D / 8); i += NTHR) {
      const int z = i / (D / 8), c = (i % (D / 8)) * 8;
      const size_t row = z < 4 ? (size_t)(z >> 1) * HP_LAT + (z & 1) * (SEQ + 1) : (size_t)HP_CTX0 + ((z - 4) >> 1) * HP_CTX + (z & 1) * (CTX + 1);
      unsigned zz = 0u; asm volatile("" : "+v"(zz));
      *(u32x4*)(H + row * D + c) = (u32x4){zz, zz, zz, zz};
    }
  }
}

__device__ __forceinline__ void phase_prep(const P& p, int layer, unsigned char* smem) {
  const int tid_ = otid(), bid_ = obid(), grd_ = ogrid(); (void)tid_; (void)bid_; (void)grd_;
  bf16_t* ACT = (bf16_t*)(p.ws + OFF_ACT);
  const int lane = tid_ & 63, wv = tid_ >> 6, gw = bid_ * 8 + wv, nw = grd_ * 8;
  float gq[8], gkv[4];
#pragma unroll
  for (int e = 0; e < 8; ++e) gq[e] = p.q_lat_g[layer * 512 + lane * 8 + e];
#pragma unroll
  for (int e = 0; e < 4; ++e) gkv[e] = p.kv_lat_g[layer * 256 + lane * 4 + e];
  for (int r = gw; r < MT; r += nw) {
    { const int s0 = r < NLAT ? (r & ~(SEQ - 1)) : NLAT + ((r - NLAT) & ~255), Ls = r < NLAT ? SEQ : CTX, t = r - s0;
      const int half = 1 << (lane >> 4); const int lo = max(t - half, 0), hi = min(t + half, Ls);
      float sum[8] = {0, 0, 0, 0, 0, 0, 0, 0}, zc[8];
      u32x4 wv_[16];
#pragma unroll
      for (int i = 0; i < 16; ++i) { const int tt = min(lo + i, hi - 1); wv_[i] = *(const u32x4*)(ACT + A_ZPOOL + (size_t)(s0 + tt) * 512 + lane * 8); }
#pragma unroll
      for (int i = 0; i < 16; ++i) { float f[8]; unpack8(wv_[i], f); const float on = (lo + i < hi) ? 1.f : 0.f;
#pragma unroll
        for (int e = 0; e < 8; ++e) sum[e] += on * f[e]; }
      unpack8(*(const u32x4*)(ACT + A_ZPOOL + (size_t)r * 512 + lane * 8), zc);
      const float ic = 1.f / (float)(hi - lo);
#pragma unroll
      for (int e = 0; e < 8; ++e) sum[e] = sum[e] * ic - zc[e];
      *(u32x4*)(ACT + A_POOLED + (size_t)r * 512 + lane * 8) = pack8(sum); }
    { float f[8]; bf16_t* zp = ACT + A_ZQ + (size_t)r * 512 + lane * 8; unpack8(*(const u32x4*)zp, f); float ss = 0.f;
#pragma unroll
      for (int e = 0; e < 8; ++e) ss += f[e] * f[e];
      ss = wave_sum(ss); const float rr = rsqrtf(ss * (1.f / 512) + EPS);
#pragma unroll
      for (int e = 0; e < 8; ++e) f[e] = f[e] * rr * gq[e];
      *(u32x4*)zp = pack8(f); }
    { bf16_t* zp = ACT + A_ZKV + (size_t)r * 256 + lane * 4; const u32x2 w = *(const u32x2*)zp;
      float f0 = bflo(w.x), f1 = bfhi(w.x), f2 = bflo(w.y), f3 = bfhi(w.y);
      float ss = wave_sum(f0 * f0 + f1 * f1 + f2 * f2 + f3 * f3); const float rr = rsqrtf(ss * (1.f / 256) + EPS);
      u32x2 o; o.x = cvtpk(f0 * rr * gkv[0], f1 * rr * gkv[1]); o.y = cvtpk(f2 * rr * gkv[2], f3 * rr * gkv[3]); *(u32x2*)zp = o; }
  }
  float gs8[8];
#pragma unroll
  for (int e = 0; e < 8; ++e) gs8[e] = p.sg_norm_g[layer * 512 + lane * 8 + e];
  for (int ci = bid_; ci < MT / 128; ci += grd_) {
    bf16_t* base = ACT + A_VG + (size_t)ci * 65536;
    for (int q = wv * 16; q < wv * 16 + 16; ++q) {
      float f[8]; unpack8(*(const u32x4*)(base + (size_t)q * 512 + lane * 8), f);
      float s = 0.f;
#pragma unroll
      for (int e = 0; e < 8; ++e) s += f[e];
      const float mean = wave_sum(s) * (1.f / 512); float v = 0.f;
#pragma unroll
      for (int e = 0; e < 8; ++e) { f[e] -= mean; v += f[e] * f[e]; }
      const float rs = rsqrtf(wave_sum(v) * (1.f / 512) + EPS);
#pragma unroll
      for (int e = 0; e < 8; e += 2) { const unsigned w = cvtpk(f[e] * rs * gs8[e], f[e + 1] * rs * gs8[e + 1]);
        *(bf16_t*)(smem + ((lane * 8 + e) * 130 + q) * 2) = (bf16_t)(w & 0xffff); *(bf16_t*)(smem + ((lane * 8 + e + 1) * 130 + q) * 2) = (bf16_t)(w >> 16); }
    }
    __syncthreads();
    for (int i = tid_; i < 8192; i += NTHR) {
      const int ch = i >> 4, q0 = (i & 15) * 8; const unsigned* lp = (const unsigned*)(smem + (ch * 130 + q0) * 2);
      u32x4 w; w.x = lp[0]; w.y = lp[1]; w.z = lp[2]; w.w = lp[3];
      *(u32x4*)(base + (size_t)ch * 128 + q0) = w;
    }
    __syncthreads();
  }
}

template <class F>
__device__ __forceinline__ void small_gemm(const bf16_t* A, long lda, const bf16_t* Bt, long ldb, int fr, int fq, F epi) {
  bf16x8 a[2][4];
#pragma unroll
  for (int mi = 0; mi < 2; ++mi)
#pragma unroll
    for (int ks = 0; ks < 4; ++ks) a[mi][ks] = *(const bf16x8*)(A + (long)(mi * 16 + fr) * lda + ks * 32 + fq * 8);
#pragma unroll 2
  for (int nj = 0; nj < 8; ++nj) {
    bf16x8 b[4];
#pragma unroll
    for (int ks = 0; ks < 4; ++ks) b[ks] = *(const bf16x8*)(Bt + (long)(nj * 16 + fr) * ldb + ks * 32 + fq * 8);
#pragma unroll
    for (int mi = 0; mi < 2; ++mi) {
      f32x4 c = {0.f, 0.f, 0.f, 0.f};
#pragma unroll
      for (int ks = 0; ks < 4; ++ks) c = __builtin_amdgcn_mfma_f32_16x16x32_bf16(b[ks], a[mi][ks], c, 0, 0, 0);
      epi(mi, nj, c);
    }
  }
}
__device__ __forceinline__ void phase_small(const P& p, int layer) {
  const int tid_ = otid(), bid_ = obid(), grd_ = ogrid(); (void)tid_; (void)bid_; (void)grd_;
  bf16_t* ACT = (bf16_t*)(p.ws + OFF_ACT); const bf16_t* WB = (const bf16_t*)(p.ws + OFF_WB);
  const int lane = tid_ & 63, fr = lane & 15, fq = lane >> 4, gw = bid_ * 8 + (tid_ >> 6), nw = grd_ * 8;
#pragma unroll 1
  for (int it = gw; it < (MT / 32) * 4; it += nw) {
    const int g = it & 3, r0 = (it >> 2) * 32;
    const float* psc = p.pool_scale + layer * 512 + g * 128 + 4 * fq; bf16_t* op = ACT + A_ZPOOL + (size_t)(r0 + fr) * 512 + g * 128 + 4 * fq;
    small_gemm(ACT + A_POOLED + (size_t)r0 * 512 + g * 128, 512, WB + W_POOL + g * 16384, 128, fr, fq, [&](int mi, int nj, f32x4 c) {
      const f32x4 v = c * *(const f32x4*)(psc + nj * 16); u32x2 w; w.x = cvtpk(v[0], v[1]); w.y = cvtpk(v[2], v[3]);
      *(u32x2*)(op + (size_t)mi * 16 * 512 + nj * 16) = w; });
  }
#pragma unroll 1
  for (int it = gw; it < (MT / 128) * 16; it += nw) {
    const int pb = it & 3, g = (it >> 2) & 3, ci = it >> 4;
    const float* bp = p.sg_b + (layer * 4 + g) * 128 + pb * 32 + fr; bf16_t* up = ACT + A_U + (size_t)(ci * 128 + pb * 32 + fr) * 512 + g * 128 + 4 * fq;
    const float bb0 = bp[0], bb1 = bp[16];
    small_gemm(WB + W_SG + g * 16384 + pb * 32 * 128, 128, ACT + A_VG + (size_t)ci * 65536 + g * 16384, 128, fr, fq, [&](int mi, int nj, f32x4 s) {
      const float bb = mi ? bb1 : bb0; bf16_t* q = up + (size_t)mi * 16 * 512 + nj * 16; const u32x2 uw = *(const u32x2*)q;
      u32x2 w; w.x = cvtpk(bflo(uw.x) * (s[0] + bb), bfhi(uw.x) * (s[1] + bb)); w.y = cvtpk(bflo(uw.y) * (s[2] + bb), bfhi(uw.y) * (s[3] + bb));
      *(u32x2*)q = w; });
  }
}

__device__ __forceinline__ void rope8(float* y, int j, int t, bool on) {
  if (!on) return;
  const int axis = j >> 2, half = (j >> 1) & 1; const float pos = (float)(axis ? (t & 63) : (t >> 6));
#pragma unroll
  for (int e = 0; e < 8; ++e) {
    const int f = (j & 1) * 8 + e;
    const float rev = pos * (exp2f(-0.8304820237218406f * (float)f) * 0.15915494309189535f);
    const float sn = __builtin_amdgcn_sinf(rev), cs = __builtin_amdgcn_cosf(rev);
    const float pr = __shfl_xor(y[e], 2);
    y[e] = half ? y[e] * cs + pr * sn : y[e] * cs - pr * sn;
  }
}
__device__ __forceinline__ void phase_qk(const P& p, int layer) {
  const int tid_ = otid(), bid_ = obid(), grd_ = ogrid(); (void)tid_; (void)bid_; (void)grd_;
  bf16_t* ACT = (bf16_t*)(p.ws + OFF_ACT);
  const int lane = tid_ & 63, h = lane >> 3, j = lane & 7, gw = bid_ * 8 + (tid_ >> 6), nw = grd_ * 8;
  float qg[3][8], kg[3][8];
#pragma unroll
  for (int i = 0; i < 3; ++i)
#pragma unroll
    for (int e = 0; e < 8; ++e) { qg[i][e] = p.q_norm_g[layer * 192 + i * 64 + j * 8 + e]; kg[i][e] = p.k_norm_g[layer * 192 + i * 64 + j * 8 + e]; }
  for (int r = gw; r < MT; r += nw) {
    const bool lat = r < NLAT; const int t = r & (SEQ - 1);
    if (lat || layer == 0) {
      bf16_t* qp = ACT + A_Q + (size_t)r * 1536 + h * 192 + j * 8; float y[3][8]; float ss = 0.f;
#pragma unroll
      for (int i = 0; i < 3; ++i) { unpack8(*(const u32x4*)(qp + i * 64), y[i]);
#pragma unroll
        for (int e = 0; e < 8; ++e) ss += y[i][e] * y[i][e]; }
      ss += __shfl_xor(ss, 1); ss += __shfl_xor(ss, 2); ss += __shfl_xor(ss, 4);
      const float rr = rsqrtf(ss * (1.f / 192) + EPS);
#pragma unroll
      for (int i = 0; i < 3; ++i)
#pragma unroll
        for (int e = 0; e < 8; ++e) y[i][e] *= rr * qg[i][e];
      rope8(y[2], j, t, lat);
#pragma unroll
      for (int i = 0; i < 3; ++i) *(u32x4*)(qp + i * 64) = pack8(y[i]);
    }
    {
      bf16_t* kp = ACT + A_K + (size_t)kv_row(r) * 1536 + h * 192 + j * 8; float y[3][8]; float ss = 0.f;
      unpack8(*(const u32x4*)(kp), y[0]); unpack8(*(const u32x4*)(kp + 64), y[1]); unpack8(*(const u32x4*)(ACT + A_ZKR + (size_t)r * 64 + j * 8), y[2]);
#pragma unroll
      for (int i = 0; i < 3; ++i)
#pragma unroll
        for (int e = 0; e < 8; ++e) ss += y[i][e] * y[i][e];
      ss += __shfl_xor(ss, 1); ss += __shfl_xor(ss, 2); ss += __shfl_xor(ss, 4);
      const float rr = rsqrtf(ss * (1.f / 192) + EPS);
#pragma unroll
      for (int i = 0; i < 3; ++i)
#pragma unroll
        for (int e = 0; e < 8; ++e) y[i][e] *= rr * kg[i][e];
      rope8(y[2], j, t, lat);
#pragma unroll
      for (int i = 0; i < 3; ++i) *(u32x4*)(kp + i * 64) = pack8(y[i]);
    }
  }
}

constexpr int LDQ = 1536, LDK = 1536, LDV = 1024, LDO = 1024;
constexpr float ASCALE = 0.07216878364870322f;
constexpr float ATHR = 8.f;
constexpr int SHM_V = 64 * 128 * 2, SHM_K = 64 * 192 * 2;
#define KADDR(row, ch24) (((ch24) >> 3) * 8192 + (row) * 128 + (((((ch24) & 7)) ^ (((row) >> 1) & 7)) << 4))
#define SBAR() __builtin_amdgcn_sched_barrier(0)
__device__ __forceinline__ int crow(int r, int hi) { return (r & 3) + 8 * (r >> 2) + 4 * hi; }
__device__ __forceinline__ void partialSM(f32x16& p0, f32x16& p1, float& m_reg, float& mn, float& alpha) {
  constexpr float C = ASCALE * 1.4426950408889634f;
  float pmax = p0[0];
#pragma unroll
  for (int r = 1; r < 16; ++r) pmax = fmaxf(pmax, p0[r]);
#pragma unroll
  for (int r = 0; r < 16; ++r) pmax = fmaxf(pmax, p1[r]);
  { auto rr = __builtin_amdgcn_permlane32_swap(__float_as_uint(pmax), __float_as_uint(pmax), false, false);
    pmax = fmaxf(__uint_as_float(rr[0]), __uint_as_float(rr[1])); }
  if (__builtin_expect(__all(pmax - m_reg <= ATHR / ASCALE), 1)) { mn = m_reg; alpha = 1.f; }
  else { mn = fmaxf(m_reg, pmax); alpha = __builtin_amdgcn_exp2f((m_reg - mn) * C); m_reg = mn; }
  const float mnC = -mn * C;
#pragma unroll
  for (int r = 0; r < 16; ++r) p0[r] = fmaf(p0[r], C, mnC);
#pragma unroll
  for (int r = 0; r < 16; ++r) p1[r] = fmaf(p1[r], C, mnC);
#pragma unroll
  for (int r = 0; r < 16; ++r) p0[r] = __builtin_amdgcn_exp2f(p0[r]);
}
__device__ __forceinline__ void finishSM(f32x16& p0, f32x16& p1, float alpha, float& l_reg, bf16x8& pa0, bf16x8& pa1, bf16x8& pa2, bf16x8& pa3) {
#pragma unroll
  for (int r = 0; r < 16; ++r) p1[r] = __builtin_amdgcn_exp2f(p1[r]);
  float ps = 0;
#pragma unroll
  for (int r = 0; r < 16; ++r) ps += p0[r];
#pragma unroll
  for (int r = 0; r < 16; ++r) ps += p1[r];
  { auto rr = __builtin_amdgcn_permlane32_swap(__float_as_uint(ps), __float_as_uint(ps), false, false);
    ps = __uint_as_float(rr[0]) + __uint_as_float(rr[1]); }
  l_reg = l_reg * alpha + ps;
#define PK4(Pv, BASE, OUT) do { unsigned a0 = cvtpk(Pv[BASE + 0], Pv[BASE + 1]), a1 = cvtpk(Pv[BASE + 2], Pv[BASE + 3]);   \
    unsigned b0 = cvtpk(Pv[BASE + 4], Pv[BASE + 5]), b1 = cvtpk(Pv[BASE + 6], Pv[BASE + 7]);                              \
    auto r0 = __builtin_amdgcn_permlane32_swap(a0, b0, false, false); auto r1 = __builtin_amdgcn_permlane32_swap(a1, b1, false, false); \
    u32x4 w = {r0[0], r1[0], r0[1], r1[1]}; OUT = *reinterpret_cast<bf16x8*>(&w); } while (0)
  PK4(p0, 0, pa0); PK4(p0, 8, pa1); PK4(p1, 0, pa2); PK4(p1, 8, pa3);
#undef PK4
}
__device__ __forceinline__ void qkt(f32x16& p0, f32x16& p1, const LAS unsigned char* Ks, const bf16x8* qr, const int* kb) {
  p0 = f32x16{}; p1 = f32x16{};
#pragma unroll
  for (int d0 = 0; d0 < 12; ++d0) {
    const bf16x8 b0 = *(const LAS bf16x8*)(Ks + kb[d0 & 3] + (d0 >> 2) * 8192);
    const bf16x8 b1 = *(const LAS bf16x8*)(Ks + kb[d0 & 3] + (d0 >> 2) * 8192 + 4096);
    p0 = __builtin_amdgcn_mfma_f32_32x32x16_bf16(b0, qr[d0], p0, 0, 0, 0);
    p1 = __builtin_amdgcn_mfma_f32_32x32x16_bf16(b1, qr[d0], p1, 0, 0, 0); }
}
__device__ __forceinline__ int v_st(int k, int c) { const int kk = (k & ~0xC) | ((k & 4) << 1) | ((k & 8) >> 1); return ((kk >> 3) * 4 + (c >> 5)) * 512 + ((kk & 7) * 32 + (c & 31)) * 2; }
__device__ __forceinline__ int v_rd_base(int lane) { return ((lane & 3) << 3) | (((lane >> 2) & 3) << 6) | (((lane >> 4) & 1) << 5) | (((lane >> 5) & 1) << 8); }
constexpr int v_rd_off(int d0, int ks, int half) { return d0 * 512 + ks * 4096 + half * 2048; }
template <int OFF> __device__ __forceinline__ s16x4 tr_read(int vb) {
  s16x4 r; asm volatile("ds_read_b64_tr_b16 %0, %1 offset:%2" : "=&v"(r) : "v"(vb), "i"(OFF) : "memory"); return r;
}
template <int D0> __device__ __forceinline__ void pv_one(f32x16& od, int vb, bf16x8 pa0, bf16x8 pa1, bf16x8 pa2, bf16x8 pa3) {
  const s16x4 l0 = tr_read<v_rd_off(D0, 0, 0)>(vb), h0 = tr_read<v_rd_off(D0, 0, 1)>(vb), l1 = tr_read<v_rd_off(D0, 1, 0)>(vb), h1 = tr_read<v_rd_off(D0, 1, 1)>(vb);
  const s16x4 l2 = tr_read<v_rd_off(D0, 2, 0)>(vb), h2 = tr_read<v_rd_off(D0, 2, 1)>(vb), l3 = tr_read<v_rd_off(D0, 3, 0)>(vb), h3 = tr_read<v_rd_off(D0, 3, 1)>(vb);
  asm volatile("s_waitcnt lgkmcnt(0)" ::: "memory"); SBAR();
#define PKV(Lo, Hi) (bf16x8){Lo[0], Lo[1], Lo[2], Lo[3], Hi[0], Hi[1], Hi[2], Hi[3]}
  od = __builtin_amdgcn_mfma_f32_32x32x16_bf16(pa0, PKV(l0, h0), od, 0, 0, 0);
  od = __builtin_amdgcn_mfma_f32_32x32x16_bf16(pa1, PKV(l1, h1), od, 0, 0, 0);
  od = __builtin_amdgcn_mfma_f32_32x32x16_bf16(pa2, PKV(l2, h2), od, 0, 0, 0);
  od = __builtin_amdgcn_mfma_f32_32x32x16_bf16(pa3, PKV(l3, h3), od, 0, 0, 0);
#undef PKV
}
__device__ __forceinline__ void pv_d0(f32x16* o, int vb, bf16x8 pa0, bf16x8 pa1, bf16x8 pa2, bf16x8 pa3) {
  pv_one<0>(o[0], vb, pa0, pa1, pa2, pa3); pv_one<1>(o[1], vb, pa0, pa1, pa2, pa3); pv_one<2>(o[2], vb, pa0, pa1, pa2, pa3); pv_one<3>(o[3], vb, pa0, pa1, pa2, pa3);
}
__device__ __forceinline__ void attn_unit(const bf16_t* Qb, const bf16_t* Kh, const bf16_t* Vh, bf16_t* Ob, int seq, LAS unsigned char* lds) {
  const int tid_ = otid(), bid_ = obid(), grd_ = ogrid(); (void)tid_; (void)bid_; (void)grd_;
  const int tid = tid_, wid = __builtin_amdgcn_readfirstlane(tid >> 6), lane = tid & 63, r32 = lane & 31, hi = lane >> 5;
  LAS unsigned char* V_lds = lds; LAS unsigned char* K_lds = lds + 2 * SHM_V;
  LAS float* wsl = (LAS float*)(lds + 2 * SHM_V + 2 * SHM_K) + wid * 64; LAS float* li_l = wsl; LAS float* al_l = wsl + 32;
  float m_reg = -1e30f, l_reg = 0; f32x16 o[4] = {}; bf16x8 qr[12];
  { const bf16_t* Qw = Qb + (size_t)(wid * 32) * LDQ; const unsigned qo = (unsigned)(r32 * LDQ + hi * 8) * 2u;
#pragma unroll
    for (int d0 = 0; d0 < 12; ++d0) qr[d0] = *(const bf16x8*)((const char*)Qw + qo + d0 * 32); }
  unsigned kgo[3], vgo[2];
#pragma unroll
  for (int i = 0; i < 3; ++i) { const int pu = (i * 8 + wid) * 64 + lane, sub = pu >> 9, row = (pu >> 3) & 63, pc = pu & 7, cch = pc ^ ((row >> 1) & 7);
    kgo[i] = (unsigned)(row * LDK + (sub * 8 + cch) * 8) * 2u; }
#pragma unroll
  for (int i = 0; i < 2; ++i) { const int u = (i * 8 + wid) * 64 + lane, st = u >> 5, kk = ((st >> 2) << 3) | ((u >> 2) & 7), cc = ((st & 3) << 5) | ((u & 3) << 3);
    const int k = (kk & ~0xC) | ((kk & 4) << 1) | ((kk & 8) >> 1); vgo[i] = (unsigned)(k * LDV + cc) * 2u; }
  int kb[4];
#pragma unroll
  for (int q = 0; q < 4; ++q) kb[q] = r32 * 128 + (((q * 2 + hi) ^ ((r32 >> 1) & 7)) << 4);
  const int vb0 = (int)(uintptr_t)V_lds + v_rd_base(lane);
  const char* Kt = (const char*)Kh; const char* Vt = (const char*)Vh;
#define DMA(b) do { \
    _Pragma("unroll") for (int _i = 0; _i < 3; ++_i) __builtin_amdgcn_global_load_lds((const unsigned*)(Kt + kgo[_i]), (LAS unsigned*)(K_lds + (b) * SHM_K + (_i * 8 + wid) * 1024), 16, 0, 0); \
    _Pragma("unroll") for (int _i = 0; _i < 2; ++_i) __builtin_amdgcn_global_load_lds((const unsigned*)(Vt + vgo[_i]), (LAS unsigned*)(V_lds + (b) * SHM_V + (_i * 8 + wid) * 1024), 16, 0, 0); \
    Kt += 64 * LDK * 2; Vt += 64 * LDV * 2; } while (0)
#define VMW() asm volatile("s_waitcnt vmcnt(0)" ::: "memory")
#define RESC(a) do { if (__any((a) < 1.f)) { if (hi == 0) al_l[r32] = (a); asm volatile("s_waitcnt lgkmcnt(0)" ::: "memory"); \
    _Pragma("unroll") for (int d = 0; d < 4; ++d) _Pragma("unroll") for (int r = 0; r < 16; ++r) o[d][r] *= al_l[crow(r, hi)]; } } while (0)
  f32x16 pA0, pA1; float mnA, alA; bf16x8 pa0, pa1, pa2, pa3; const int NT = seq / 64;
  DMA(0); VMW(); __syncthreads();
  for (int j = 0; j < NT; j += 2) {
    DMA(1); SBAR();
    qkt(pA0, pA1, K_lds, qr, kb); partialSM(pA0, pA1, m_reg, mnA, alA);
    finishSM(pA0, pA1, alA, l_reg, pa0, pa1, pa2, pa3); RESC(alA); SBAR();
    pv_d0(o, vb0, pa0, pa1, pa2, pa3);
    VMW(); __syncthreads();
    if (j + 2 < NT) DMA(0); SBAR();
    qkt(pA0, pA1, K_lds + SHM_K, qr, kb); partialSM(pA0, pA1, m_reg, mnA, alA);
    finishSM(pA0, pA1, alA, l_reg, pa0, pa1, pa2, pa3); RESC(alA); SBAR();
    pv_d0(o, vb0 + SHM_V, pa0, pa1, pa2, pa3);
    VMW(); __syncthreads();
  }
  if (hi == 0) li_l[r32] = l_reg; asm volatile("s_waitcnt lgkmcnt(0)" ::: "memory");
  bf16_t* Ow = Ob + (size_t)(wid * 32) * LDO;
#pragma unroll
  for (int r = 0; r < 16; ++r) { const int orow = crow(r, hi); const float rl = __builtin_amdgcn_rcpf(li_l[orow]);
#pragma unroll
    for (int d0 = 0; d0 < 4; ++d0) Ow[orow * LDO + d0 * 32 + r32] = (bf16_t)(cvtpk(o[d0][r] * rl, 0.f) & 0xffff); }
  __syncthreads();
#undef DMA
#undef VMW
#undef RESC
}
__device__ __forceinline__ void phase_attn(const P& p, int layer, unsigned char* smem) {
  const int tid_ = otid(), bid_ = obid(), grd_ = ogrid(); (void)tid_; (void)bid_; (void)grd_;
  bf16_t* ACT = (bf16_t*)(p.ws + OFF_ACT);
  const int G = grd_, c = bid_;
  for (int u = c; u < 1024; u += G) {
    int bh, qb;
    if (G == 256) { const int i = u >> 8, x = c & 7, j = c >> 3; bh = i * 4 + (x >> 1); qb = (x & 1) * 32 + j; } else { bh = u >> 6; qb = u & 63; }
    const int b = bh >> 3, h = bh & 7; const size_t qrow = (size_t)b * SEQ + qb * 256, krow = (size_t)b * KVS;
    attn_unit(ACT + A_Q + qrow * LDQ + h * 192, ACT + A_K + krow * LDK + h * 192, ACT + A_V + krow * LDV + h * 128, ACT + A_ATT + qrow * LDO + h * 128, KVS, (LAS unsigned char*)smem);
  }
  if (layer == 0) for (int u = c; u < 16; u += G) {
    const int b = u >> 3, h = u & 7; const size_t qrow = (size_t)NLAT + b * CTX, krow = (size_t)b * KVS + SEQ;
    attn_unit(ACT + A_Q + qrow * LDQ + h * 192, ACT + A_K + krow * LDK + h * 192, ACT + A_V + krow * LDV + h * 128, ACT + A_ATT + qrow * LDO + h * 128, CTX, (LAS unsigned char*)smem);
  }
}

#ifndef TESTMASK
#define TESTMASK 0xFFFF
#endif
#define RUNPH(n) ((TESTMASK >> (n)) & 1)
template <unsigned MASK = 0x3fffffffu>
__device__ __forceinline__ P load_params() {
  P r{}; const volatile __attribute__((address_space(4))) unsigned long long* kp = (const volatile __attribute__((address_space(4))) unsigned long long*)__builtin_amdgcn_kernarg_segment_ptr();
  const float** d = (const float**)&r;
#pragma unroll
  for (int i = 0; i < 30; ++i) if ((MASK >> i) & 1u) d[i] = (const float*)(const __attribute__((address_space(1))) float*)kp[i];
  return r;
}
constexpr unsigned M_WS = 1u << 29, M_OUT = 1u << 28, M_IO = M_WS | M_OUT | 1u | (1u << 2);
__device__ __forceinline__ int opq(int v) { asm volatile("" : "+s"(v)); return v; }
#define ENV() const int G = ogrid(), c = obid(); (void)G; (void)c; const P p = load_params<M_IO | (1u << 6) | (1u << 23) | (1u << 25) | (1u << 26)>(); bf16_t* ACT = (bf16_t*)(p.ws + OFF_ACT); const bf16_t* WB = (const bf16_t*)(p.ws + OFF_WB); bf16_t* H = (bf16_t*)(p.ws + OFF_H); \
  float* XC = (float*)(p.ws + OFF_XC); const float* modl = (const float*)(p.ws + OFF_MOD) + layer * 3 * 12288; \
  const float* xlat = layer ? p.out : p.x; const float* xctx = layer ? XC : p.ctx; (void)ACT; (void)WB; (void)H; (void)XC; (void)modl; (void)xlat; (void)xctx;

#ifndef DBG_MERGE
#define DBG_MERGE 0
#endif
#ifndef DBG_STOP
#define DBG_STOP 0
#endif
__device__ __forceinline__ void dbg_dump(const bf16_t* src, size_t nelem, const bf16_t* src2 = nullptr, size_t nelem2 = 1) {
  const P p = load_params<M_OUT>(); const size_t n = (size_t)NLAT * D;
  for (size_t i = (size_t)blockIdx.x * NTHR + threadIdx.x; i < n; i += (size_t)gridDim.x * NTHR)
    p.out[i] = (src2 && i >= n / 2) ? bflo((unsigned)src2[(i - n / 2) % nelem2]) : bflo((unsigned)src[i % nelem]);
}
#define DBG(k, off, ne) if (DBG_STOP == (k) && layer == 0) { dbg_dump((const bf16_t*)(load_params<M_WS>().ws + OFF_ACT) + (off), (ne)); return; }
__global__ void __launch_bounds__(NTHR, 2) mega(P p_arg) {
  extern __shared__ __attribute__((aligned(16))) unsigned char smem[];
  cg::grid_group grid = cg::this_grid();
  unsigned nbar = 0;
#define GSYNC() do { ++nbar; grid_barrier((unsigned*)(load_params<M_WS>().ws + OFF_CTL), nbar * gridDim.x); } while (0)
  LAS unsigned char* lds3 = (LAS unsigned char*)smem;

  grid.sync();
  if (RUNPH(0)) { const P p = load_params(); phase_mod(p, smem); phase_cvt(p, 0, smem); }
  GSYNC();

#pragma unroll 1
  for (int layer = 0; layer < 2; ++layer) {
    const int nMr = layer == 0 ? 130 : 128;
    if (RUNPH(0)) if (layer == 1) { const P p = load_params(); phase_cvt(p, 1, smem); }
    if (RUNPH(1)) { ENV(); phase_norm(xlat, xctx, p.norm1_g + layer * D, modl, 0, 1, H, false, MT); }
    GSYNC();
    if (DBG_STOP == 8 && layer == 0) { dbg_dump((const bf16_t*)(load_params<M_WS>().ws + OFF_WB), W_END); return; }
    if (DBG_STOP == 9 && layer == 0) { dbg_dump((const bf16_t*)(load_params<M_WS>().ws + OFF_H), (size_t)MT * D); return; }
    if (RUNPH(2)) { ENV();
#pragma unroll 1
      for (int L = c; L < 130 * 10; L += G) {
        int pm, pn; tile_order(L, 130, 10, pm, pn); pm = opq(pm); pn = opq(pn);
        bf16_t* dst; unsigned ld; int ncols = 256, act = 0;
        if (pn < 2) { dst = ACT + A_ZPOOL + (size_t)pm * 256 * 512 + pn * 256; ld = 512; }
        else if (pn < 4) { dst = ACT + A_ZQ + (size_t)pm * 256 * 512 + (pn - 2) * 256; ld = 512; }
        else if (pn == 4) { dst = ACT + A_ZKV + (size_t)pm * 256 * 256; ld = 256; }
        else if (pn == 5) { dst = ACT + A_ZKR + (size_t)pm * 256 * 64; ld = 64; ncols = 64; }
        else if (pn < 8) { dst = ACT + A_U + (size_t)pm * 256 * 512 + (pn - 6) * 256; ld = 512; act = 1; }
        else { dst = ACT + A_VG + (size_t)pm * 256 * 512 + (pn - 8) * 256; ld = 512; act = 1; }
        const bf16_t* Ap = H + (size_t)pm * 256 * D; const bf16_t* Bp = WB + W_SM + (size_t)pn * 256 * D;
        if (act) gemm_tile(Ap, D, Bp, D, D, lds3, EpiBf16<1>{dst, ld, ncols});
        else gemm_tile(Ap, D, Bp, D, D, lds3, EpiBf16<0>{dst, ld, ncols});
      } }
    GSYNC();
    DBG(1, A_ZQ, (size_t)MT * 512)
    if (RUNPH(3)) { const P p = load_params<M_WS | (1u << 10) | (1u << 12) | (1u << 16)>(); phase_prep(p, layer, smem); }
    GSYNC();
    if (RUNPH(4)) { ENV();
#pragma unroll 1
      for (int L = c; L < nMr * 6; L += G) {
        int pm, pn; tile_order(L, nMr, 6, pm, pn); pm = opq(pm); pn = opq(pn);
        gemm_tile(ACT + A_ZQ + (size_t)pm * 256 * 512, 512, WB + W_UQ + (size_t)pn * 256 * 512, 512, 512, lds3, EpiBf16<0>{ACT + A_Q + (size_t)pm * 256 * 1536 + pn * 256, 1536, 256});
      }
#pragma unroll 1
      for (int L = c; L < 130 * 8; L += G) {
        int pm, pn; tile_order(L, 130, 8, pm, pn); pm = opq(pm); pn = opq(pn);
        const size_t kr = kv_row(pm * 256);
        gemm_tile(ACT + A_ZKV + (size_t)pm * 256 * 256, 256, WB + W_UKV + (size_t)pn * 256 * 256, 256, 256, lds3, EpiKV{ACT + A_K + kr * 1536 + pn * 192, ACT + A_V + kr * 1024 + pn * 128});
      } }
    if (RUNPH(5)) { const P p = load_params<M_WS | (1u << 9) | (1u << 18)>(); phase_small(p, layer); }
    GSYNC();
    if (RUNPH(6)) { const P p = load_params<M_WS | (1u << 14) | (1u << 15)>(); phase_qk(p, layer); }
    GSYNC();
    DBG(2, A_K, (size_t)MT * 1536)
    if (DBG_STOP == 7 && layer == 0) { const bf16_t* a = (const bf16_t*)(load_params<M_WS>().ws + OFF_ACT); dbg_dump(a + A_ZPOOL, (size_t)MT * 512, a + A_U, (size_t)MT * 512); return; }
    if (RUNPH(7)) { const P p = load_params<M_WS>(); phase_attn(p, layer, smem); }
    GSYNC();
    DBG(3, A_ATT, (size_t)MT * 1024)
    if (RUNPH(8)) { const int G0 = ogrid(), c0 = obid();
#define MENV() ENV(); const int pm_ = opq(pm), pn_ = opq(pn); \
          unsigned char* s0 = p.ws + OFF_GS + (size_t)c * 131072; unsigned char* s1 = p.ws + OFF_YS + (size_t)c * 262144; unsigned char* s2 = s1 + 131072; \
          bf16_t* yp = ACT + A_Y + (size_t)pm_ * 256 * D + pn_ * 256; const bf16_t* gA = H + (size_t)pm_ * 256 * D; (void)yp; (void)gA; (void)s0; (void)s2;
#pragma unroll 1
      for (int L = c0; L < nMr * 8; L += G0) {
        int pm, pn; tile_order(L, nMr, 8, pm, pn);
        { MENV(); gemm_tile(gA, D, WB + W_G + (size_t)(0 * 2048 + pn_ * 256) * D, D, D, lds3, EpiGateR<0, false>{s0, s1, s2, 15}); }
        { MENV(); gemm_tile(gA, D, WB + W_G + (size_t)(1 * 2048 + pn_ * 256) * D, D, D, lds3, EpiGateR<1, false>{s0, s1, s2, 15}); }
        { MENV(); gemm_tile(gA, D, WB + W_G + (size_t)(2 * 2048 + pn_ * 256) * D, D, D, lds3, EpiGateR<2, false>{s0, s1, s2, 15}); }
        { Acc acc;
          { MENV(); gemm_tile_acc<true, false>(ACT + A_ZPOOL + (size_t)pm_ * 256 * 512, 512, WB + W_BP + (size_t)pn_ * 256 * 512, 512, 512, lds3, acc, EpiScale<false, false>{s0, yp, 15}); }
          { MENV(); gemm_tile_acc<false, false>(ACT + A_ATT + (size_t)pm_ * 256 * 1024, 1024, WB + W_BM + (size_t)pn_ * 256 * 1024, 1024, 1024, lds3, acc, EpiScale<false, false>{s1, yp, 15}); }
          { MENV(); gemm_tile_acc<false, false>(ACT + A_U + (size_t)pm_ * 256 * 512, 512, WB + W_BS + (size_t)pn_ * 256 * 512, 512, 512, lds3, acc, EpiScale<true, false>{s2, yp, 15}); } }
      }
#undef MENV
    }
    GSYNC();
    DBG(4, A_Y, (size_t)NLAT * D)
    if (RUNPH(9)) { ENV(); const int nFull = 128 * 8, nUnits = nFull + (layer == 0 ? 64 : 0);
#pragma unroll 1
      for (int L = c; L < nUnits; L += G) {
        int pm, pn, qmk = 15;
        if (L < nFull) tile_order(L, 128, 8, pm, pn); else { const int t = (L - nFull) >> 2; pm = 128 + (t >> 3); pn = t & 7; qmk = 1 << ((L - nFull) & 3); }
        pm = opq(pm); pn = opq(pn); qmk = opq(qmk);
        const int r0 = pm * 256; const float* gate = modl + mod_row(r0) * 12288 + 2 * 2048 + pn * 256;
        const float* xin = (r0 < NLAT ? xlat + (size_t)r0 * D : xctx + (size_t)(r0 - NLAT) * D) + pn * 256;
        float* xo = (r0 < NLAT ? p.out + (size_t)r0 * D : XC + (size_t)(r0 - NLAT) * D) + pn * 256;
        Acc acc;
        if (L < nFull) gemm_tile_acc<true, false>(ACT + A_Y + (size_t)r0 * D, D, WB + W_O + (size_t)pn * 256 * D, D, D, lds3, acc, EpiRes<false>{xin, xo, gate, 15});
        else gemm_tile_acc<true, true>(ACT + A_Y + (size_t)r0 * D, D, WB + W_O + (size_t)pn * 256 * D, D, D, lds3, acc, EpiRes<true>{xin, xo, gate, qmk}, qmk);
      } }
    GSYNC();
    if (DBG_STOP == 5 && layer == 0) return;
    if (RUNPH(1)) { ENV(); phase_norm(p.out, XC, p.norm2_g + layer * D, modl, 3, 4, H, true, layer == 0 ? MT : NLAT); }
    GSYNC();
    if (RUNPH(10)) { ENV(); const int nMf = layer == 0 ? 133 : 130;
#pragma unroll 1
      for (int L = c; L < nMf * 44; L += G) {
        int pm, pn; tile_order(L, nMf, 44, pm, pn); pm = opq(pm); pn = opq(pn);
        size_t hrow, frow; int nvalid, hole = 100000;
        if (pm < 130) { const int b = pm / 65, i = pm % 65; hrow = (size_t)b * HP_LAT + i * 254; frow = (size_t)b * SEQ + i * 254; nvalid = min(254, SEQ - i * 254); }
        else { const int i = pm - 130; hrow = (size_t)HP_CTX0 + i * 254; frow = (size_t)NLAT + i * 254; nvalid = i == 2 ? 6 : 254; hole = i == 0 ? 100000 : (i == 1 ? 3 : -2); }
        gemm_tile(H + hrow * D, D, WB + W_UP + (size_t)pn * 256 * D, D, D, lds3,
                  EpiConv{lds3, p.ffn_conv_w + (size_t)layer * 3 * F2, p.ffn_conv_b + (size_t)layer * F2, ACT + A_F + frow * DFF, pn * 128, nvalid, hole});
      } }
    GSYNC();
    DBG(6, A_F, (size_t)NLAT * D)
    if (RUNPH(11)) { ENV(); const int nFull = 128 * 8, nUnits = nFull + (layer == 0 ? 64 : 0);
#pragma unroll 1
      for (int L = c; L < nUnits; L += G) {
        int pm, pn, qmk = 15;
        if (L < nFull) tile_order(L, 128, 8, pm, pn); else { const int t = (L - nFull) >> 2; pm = 128 + (t >> 3); pn = t & 7; qmk = 1 << ((L - nFull) & 3); }
        pm = opq(pm); pn = opq(pn); qmk = opq(qmk);
        const int r0 = pm * 256; const float* gate = modl + mod_row(r0) * 12288 + 5 * 2048 + pn * 256;
        float* xo = (r0 < NLAT ? p.out + (size_t)r0 * D : XC + (size_t)(r0 - NLAT) * D) + pn * 256;
        Acc acc;
        if (L < nFull) gemm_tile_acc<true, false>(ACT + A_F + (size_t)r0 * DFF, DFF, WB + W_DN + (size_t)pn * 256 * DFF, DFF, DFF, lds3, acc, EpiRes<false>{xo, xo, gate, 15});
        else gemm_tile_acc<true, true>(ACT + A_F + (size_t)r0 * DFF, DFF, WB + W_DN + (size_t)pn * 256 * DFF, DFF, DFF, lds3, acc, EpiRes<true>{xo, xo, gate, qmk}, qmk);
      } }
    if (layer == 0) GSYNC();
  }
}

extern "C" void kernel_launch(void* const* d_in, const int* in_sizes, int n_in, void* d_out, int out_size, void* d_ws, size_t ws_size, hipStream_t stream) {
  static int grid_blocks = 0;
  if (grid_blocks == 0) {
    if (n_in != 28 || ws_size < WS_NEED) { fprintf(stderr, "kernel_launch: n_in %d ws %zu (need %zu)\n", n_in, ws_size, (size_t)WS_NEED); grid_blocks = -1; return; }
    int dev = 0, cus = 0, per_cu = 0;
    hipGetDevice(&dev);
    hipDeviceGetAttribute(&cus, hipDeviceAttributeMultiprocessorCount, dev);
    if (hipFuncSetAttribute((const void*)mega, hipFuncAttributeMaxDynamicSharedMemorySize, LDS_BYTES) != hipSuccess) { fprintf(stderr, "kernel_launch: LDS attribute failed\n"); grid_blocks = -1; return; }
    hipOccupancyMaxActiveBlocksPerMultiprocessor(&per_cu, (const void*)mega, NTHR, LDS_BYTES);
    if (per_cu < 1) { fprintf(stderr, "kernel_launch: occupancy query %d\n", per_cu); per_cu = 1; }
    (void)hipGetLastError();
    grid_blocks = cus;
    if (grid_blocks > 256) grid_blocks = 256;
  }
  if (grid_blocks < 0) return;
  hipMemsetAsync((char*)d_ws + OFF_CTL, 0, 4096, stream);
  P p{};
  const float** pp = (const float**)&p;
  for (int i = 0; i < 28; ++i) pp[i] = (const float*)d_in[i];
  p.out = (float*)d_out; p.ws = (unsigned char*)d_ws;
  void* args[] = {&p};
  hipError_t e = hipLaunchCooperativeKernel((const void*)mega, dim3(grid_blocks), dim3(NTHR), args, LDS_BYTES, stream);
  if (e != hipSuccess) fprintf(stderr, "cooperative launch failed: %s (grid %d)\n", hipGetErrorString(e), grid_blocks);
}
```

```cpp
#include <hip/hip_runtime.h>
#include <hip/hip_cooperative_groups.h>
#include <cstdio>
#include <cstdint>
namespace cg = cooperative_groups;

typedef unsigned short bf16_t;
typedef short bf16x8 __attribute__((ext_vector_type(8)));
typedef short s16x4 __attribute__((ext_vector_type(4)));
typedef float f32x4 __attribute__((ext_vector_type(4)));
typedef float f32x16 __attribute__((ext_vector_type(16)));
typedef unsigned u32x4 __attribute__((ext_vector_type(4)));
typedef unsigned u32x2 __attribute__((ext_vector_type(2)));
#define LAS __attribute__((address_space(3)))

constexpr int D = 2048, NB = 2, SEQ = 16384, CTX = 256, NLAT = NB * SEQ, NCTX = NB * CTX, MT = NLAT + NCTX;
constexpr int INC = 8512, F2 = 11264, DFF = 5632, KVS = SEQ + CTX;
constexpr int NTHR = 512;
constexpr float EPS = 1e-6f;
constexpr int HROWS = 33600;
constexpr int HP_LAT = SEQ + 2, HP_CTX0 = 2 * HP_LAT, HP_CTX = CTX + 2;

constexpr size_t al256(size_t x) { return (x + 255) & ~(size_t)255; }
constexpr size_t OFF_CTL = 0;
constexpr size_t OFF_MOD = 4096;
constexpr size_t OFF_XC = al256(OFF_MOD + 2 * 3 * 12288 * 4);
constexpr size_t OFF_WB = al256(OFF_XC + (size_t)NCTX * D * 4);
constexpr size_t W_SM = 0;
constexpr size_t W_G = W_SM + (size_t)2560 * 2048;
constexpr size_t W_UQ = W_G + (size_t)6144 * 2048;
constexpr size_t W_UKV = W_UQ + (size_t)1536 * 512;
constexpr size_t W_POOL = W_UKV + (size_t)2048 * 256;
constexpr size_t W_SG = W_POOL + 65536;
constexpr size_t W_BP = W_SG + 65536;
constexpr size_t W_BM = W_BP + (size_t)2048 * 512;
constexpr size_t W_BS = W_BM + (size_t)2048 * 1024;
constexpr size_t W_O = W_BS + (size_t)2048 * 512;
constexpr size_t W_UP = W_O + (size_t)2048 * 2048;
constexpr size_t W_DN = W_UP + (size_t)F2 * 2048;
constexpr size_t W_END = W_DN + (size_t)2048 * DFF;
constexpr size_t OFF_H = al256(OFF_WB + W_END * 2);
constexpr size_t OFF_GS = al256(OFF_H + (size_t)HROWS * D * 2);
constexpr size_t OFF_YS = al256(OFF_GS + (size_t)256 * 131072);
constexpr size_t OFF_ACT = al256(OFF_YS + (size_t)256 * 262144);
constexpr size_t A_ZPOOL = 0;
constexpr size_t A_POOLED = A_ZPOOL + (size_t)MT * 512;
constexpr size_t A_ZQ = A_POOLED + (size_t)MT * 512;
constexpr size_t A_ZKV = A_ZQ + (size_t)MT * 512;
constexpr size_t A_ZKR = A_ZKV + (size_t)MT * 256;
constexpr size_t A_U = A_ZKR + (size_t)MT * 64;
constexpr size_t A_VG = A_U + (size_t)MT * 512;
constexpr size_t A_Q = A_VG + (size_t)MT * 512;
constexpr size_t A_K = A_Q + (size_t)MT * 1536;
constexpr size_t A_V = A_K + (size_t)MT * 1536;
constexpr size_t A_ATT = A_V + (size_t)MT * 1024;
constexpr size_t A_END = A_ATT + (size_t)MT * 1024;
constexpr size_t A_Y = A_END;
constexpr size_t A_F = 0;
static_assert((size_t)MT * DFF <= A_END, "f fits");
constexpr size_t WS_NEED = OFF_ACT + (A_END + (size_t)MT * 2048) * 2;
static_assert(WS_NEED <= ((size_t)1 << 30), "workspace plan must fit 1 GiB");

constexpr int LDS_BYTES = 139264;

struct P {
  const float *x, *c, *ctx, *c_ctx, *ada_w, *ada_b, *norm1_g, *w_in, *pool_w, *pool_scale, *q_lat_g, *w_uq, *kv_lat_g, *w_ukv, *q_norm_g, *k_norm_g,
      *sg_norm_g, *sg_w, *sg_b, *w_br_pool, *w_br_mla, *w_br_sg, *w_o, *norm2_g, *ffn_up, *ffn_conv_w, *ffn_conv_b, *ffn_down;
  float* out; unsigned char* ws;
};

typedef __bf16 bf16v2 __attribute__((ext_vector_type(2)));
typedef float f32x2 __attribute__((ext_vector_type(2)));
__device__ __forceinline__ unsigned cvtpk(float lo, float hi) { f32x2 v = {lo, hi}; bf16v2 b = __builtin_convertvector(v, bf16v2); return __builtin_bit_cast(unsigned, b); }
__device__ __forceinline__ float bflo(unsigned u) { return __uint_as_float(u << 16); }
__device__ __forceinline__ float bfhi(unsigned u) { return __uint_as_float(u & 0xffff0000u); }
__device__ __forceinline__ float wave_sum(float v) {
#pragma unroll
  for (int o = 32; o > 0; o >>= 1) v += __shfl_xor(v, o);
  return v;
}
__device__ __forceinline__ int otid() { int t = threadIdx.x; asm volatile("" : "+v"(t)); return t; }
__device__ __forceinline__ int obid() { int t = blockIdx.x; asm volatile("" : "+s"(t)); return t; }
__device__ __forceinline__ int ogrid() { int t = gridDim.x; asm volatile("" : "+s"(t)); return t; }
__device__ __forceinline__ float sigmoidf_(float x) { return __builtin_amdgcn_rcpf(1.f + __expf(-x)); }
__device__ __forceinline__ float gelu_tanh(float x) { const float u = 1.5957691216057308f * (x + 0.044715f * x * x * x); return x * __builtin_amdgcn_rcpf(1.f + __expf(-u)); }
__device__ __forceinline__ void unpack8(u32x4 w, float* f) {
  f[0] = bflo(w.x); f[1] = bfhi(w.x); f[2] = bflo(w.y); f[3] = bfhi(w.y); f[4] = bflo(w.z); f[5] = bfhi(w.z); f[6] = bflo(w.w); f[7] = bfhi(w.w);
}
__device__ __forceinline__ u32x4 pack8(const float* f) { u32x4 w; w.x = cvtpk(f[0], f[1]); w.y = cvtpk(f[2], f[3]); w.z = cvtpk(f[4], f[5]); w.w = cvtpk(f[6], f[7]); return w; }

__device__ __forceinline__ void grid_barrier(unsigned* ctr, unsigned target) {
  asm volatile("s_waitcnt vmcnt(0) lgkmcnt(0)" ::: "memory");
  __syncthreads();
  if (threadIdx.x == 0) {
    __builtin_amdgcn_fence(__ATOMIC_RELEASE, "agent");
    asm volatile("s_waitcnt vmcnt(0)" ::: "memory");
    __hip_atomic_fetch_add(ctr, 1u, __ATOMIC_RELAXED, __HIP_MEMORY_SCOPE_AGENT);
    while (__hip_atomic_load(ctr, __ATOMIC_RELAXED, __HIP_MEMORY_SCOPE_AGENT) < target) __builtin_amdgcn_s_sleep(2);
    __builtin_amdgcn_fence(__ATOMIC_ACQUIRE, "agent");
    asm volatile("s_waitcnt vmcnt(0)" ::: "memory");
  }
  __syncthreads();
}

__device__ __forceinline__ int kv_row(int r) { return r < NLAT ? (r >> 14) * KVS + (r & (SEQ - 1)) : ((r - NLAT) >> 8) * KVS + SEQ + ((r - NLAT) & 255); }
__device__ __forceinline__ int mod_row(int r) { return r < NLAT ? (r >> 14) : 2; }

__device__ __forceinline__ void tile_order(int L, int nM, int nN, int& pm, int& pn) {
  const int nwg = nM * nN; int wgid = L;
  { const int q = nwg / 8, r = nwg % 8, xcd = wgid % 8, off = wgid / 8; wgid = (xcd < r ? xcd * (q + 1) : r * (q + 1) + (xcd - r) * q) + off; }
  const int nig = 2 * nN, gid = wgid / nig, fm = gid * 2, gsz = (nM - fm) < 2 ? (nM - fm) : 2;
  pm = fm + ((wgid % nig) % gsz); pn = (wgid % nig) / gsz;
}

__device__ __forceinline__ int lds_byte(int r, int c) { int st = (r >> 4) * 2 + (c >> 5), rr = r & 15, cc = c & 31, ob = rr * 64 + cc * 2; return st * 1024 + (ob ^ (((ob >> 9) & 1) << 5)); }
__device__ __forceinline__ void stage_rc(int b, int& R, int& C) { int st = b / 1024, sb = b % 1024, swz = sb ^ (((sb >> 9) & 1) << 5); R = (st >> 1) * 16 + swz / 64; C = (st & 1) * 32 + (swz % 64) / 2; }
#define GL_LDS(gp, lp) __builtin_amdgcn_global_load_lds((const __attribute__((address_space(1))) unsigned*)(gp), (__attribute__((address_space(3))) unsigned*)(lp), 16, 0, 0)

typedef f32x4 Acc[2][2][4][2];
#define QON(ai_, bj_) (!PART || ((qm >> ((ai_) * 2 + (bj_))) & 1))
template <bool ZERO, bool PART, class Epi>
__device__ __forceinline__ void gemm_tile_acc(const bf16_t* A, unsigned lda, const bf16_t* Bt, unsigned ldb, int K, LAS unsigned char* lds, Acc& acc, const Epi& epi, int qm = 15) {
  int tid = threadIdx.x; asm volatile("" : "+v"(tid));
  const int wid = __builtin_amdgcn_readfirstlane(tid >> 6), lane = tid & 63, wr = wid >> 2, wc = wid & 3, fr = lane & 15, fq = lane >> 4;
  unsigned voffA[2], voffB[2];
#pragma unroll
  for (int i = 0; i < 2; ++i) { int R, C; stage_rc(tid * 16 + i * 8192, R, C); voffA[i] = (unsigned)(R * lda + C) * 2u; voffB[i] = (unsigned)(R * ldb + C) * 2u; }
  const unsigned ldsw = (unsigned)wid * 1024u;
  const int aoff = lds_byte(wr * 64 + fr, fq * 8), boff = lds_byte(wc * 32 + fr, fq * 8);
  const char* cA = (const char*)A; const char* cB = (const char*)Bt;
  const size_t hA = (size_t)128 * lda * 2, hB = (size_t)128 * ldb * 2;
#define SAo(b, h) (((b) * 2 + (h)) * 16384)
#define SBo(b, h) ((4 + (b) * 2 + (h)) * 16384)
#define STG(bufoff, gbase, voff) do { _Pragma("unroll") for (int _i = 0; _i < 2; ++_i) \
    __builtin_amdgcn_global_load_lds((const unsigned*)((const char*)(gbase) + (voff)[_i]), (LAS unsigned*)(lds + (bufoff) + ldsw + _i * 8192), 16, 0, 0); } while (0)
#define STA(b, h, kt) STG(SAo(b, h), cA + (h) * hA + (size_t)(kt) * 128, voffA)
#define STB(b, h, kt) STG(SBo(b, h), cB + (h) * hB + (size_t)(kt) * 128, voffB)
#define LDA(dst, b, h) do { _Pragma("unroll") for (int m = 0; m < 4; ++m) _Pragma("unroll") for (int k = 0; k < 2; ++k) dst[m][k] = *(const LAS bf16x8*)(lds + SAo(b, h) + aoff + m * 2048 + k * 1024); } while (0)
#define LDB(dst, b, h) do { _Pragma("unroll") for (int n = 0; n < 2; ++n) _Pragma("unroll") for (int k = 0; k < 2; ++k) dst[n][k] = *(const LAS bf16x8*)(lds + SBo(b, h) + boff + n * 2048 + k * 1024); } while (0)
#define MMA(ai, bj, At_, Bt_) do { __builtin_amdgcn_s_setprio(1); \
    _Pragma("unroll") for (int m = 0; m < 4; ++m) _Pragma("unroll") for (int n = 0; n < 2; ++n) _Pragma("unroll") for (int k = 0; k < 2; ++k) \
      acc[ai][bj][m][n] = __builtin_amdgcn_mfma_f32_16x16x32_bf16(Bt_[n][k], At_[m][k], acc[ai][bj][m][n], 0, 0, 0); \
    __builtin_amdgcn_s_setprio(0); } while (0)
#define WAIT_V(n) asm volatile("s_waitcnt vmcnt(" #n ")" ::: "memory")
#define WAIT_L(n) asm volatile("s_waitcnt lgkmcnt(" #n ")" ::: "memory")
#define BAR __builtin_amdgcn_s_barrier()
#define SCHED __builtin_amdgcn_sched_barrier(0)
  if (ZERO) {
  float z0 = 0.f; asm volatile("" : "+v"(z0));
#pragma unroll
  for (int a = 0; a < 2; ++a)
#pragma unroll
    for (int b = 0; b < 2; ++b)
#pragma unroll
      for (int m = 0; m < 4; ++m)
#pragma unroll
        for (int n = 0; n < 2; ++n) acc[a][b][m][n] = (f32x4){z0, z0, z0, z0};
  }
#define MMQ(ai, bj, At_, Bt_) do { if (!PART || ((qm >> ((ai) * 2 + (bj))) & 1)) MMA(ai, bj, At_, Bt_); } while (0)
  bf16x8 At[4][2], B0[2][2], B1[2][2];
  const int nt = K / 64;
  STB(0, 0, 0); STB(0, 1, 0); STA(0, 0, 0); STA(0, 1, 0);
  if (wr == 1) BAR;
  WAIT_V(2); BAR;
  STB(1, 0, 1); STA(1, 0, 1); STB(1, 1, 1);
  WAIT_V(6); BAR;
  for (int t = 0; t < nt - 2; t += 2) {
    const int k2 = t + 2;
    LDB(B0, 0, 0); LDB(B1, 0, 1); SCHED; LDA(At, 0, 0); STA(1, 1, t + 1);
    WAIT_V(8); WAIT_L(0); BAR; MMQ(0, 0, At, B0); MMQ(0, 1, At, B1); BAR; SCHED;
    LDA(At, 0, 1); STB(0, 0, k2); STB(0, 1, k2); STA(0, 0, k2);
    WAIT_V(8); WAIT_L(0); BAR; MMQ(1, 0, At, B0); MMQ(1, 1, At, B1); BAR; SCHED;
    LDB(B0, 1, 0); LDB(B1, 1, 1); SCHED; LDA(At, 1, 0); STA(0, 1, k2);
    WAIT_V(8); WAIT_L(0); BAR; MMQ(0, 0, At, B0); MMQ(0, 1, At, B1); BAR; SCHED;
    LDA(At, 1, 1); STB(1, 0, k2 + 1); STB(1, 1, k2 + 1); STA(1, 0, k2 + 1);
    WAIT_V(8); WAIT_L(0); BAR; MMQ(1, 0, At, B0); MMQ(1, 1, At, B1); BAR; SCHED;
  }
  {
    LDB(B0, 0, 0); LDB(B1, 0, 1); SCHED; LDA(At, 0, 0); STA(1, 1, nt - 1);
    WAIT_V(8); WAIT_L(0); BAR; MMQ(0, 0, At, B0); MMQ(0, 1, At, B1); BAR; SCHED;
    LDA(At, 0, 1);
    WAIT_V(2); WAIT_L(0); BAR; MMQ(1, 0, At, B0); MMQ(1, 1, At, B1); BAR; SCHED;
    LDB(B0, 1, 0); LDB(B1, 1, 1); SCHED; LDA(At, 1, 0);
    WAIT_V(0); WAIT_L(0); BAR; MMQ(0, 0, At, B0); MMQ(0, 1, At, B1); BAR; SCHED;
    LDA(At, 1, 1);
    WAIT_L(0); BAR; MMQ(1, 0, At, B0); MMQ(1, 1, At, B1); BAR; SCHED;
  }
  WAIT_V(0);
  if (wr == 0) BAR;
  BAR;
  epi(acc, wr, wc, fr, fq);
}
template <class Epi>
__device__ __forceinline__ void gemm_tile(const bf16_t* A, unsigned lda, const bf16_t* Bt, unsigned ldb, int K, LAS unsigned char* lds, const Epi& epi) {
  Acc acc; gemm_tile_acc<true, false>(A, lda, Bt, ldb, K, lds, acc, epi);
}

template <int ACT> struct EpiBf16 {
  bf16_t* dst; unsigned ld; int ncols;
  __device__ __forceinline__ void operator()(Acc& acc, int wr, int wc, int fr, int fq) const {
    bf16_t* d0 = dst + (size_t)(wr * 64) * ld + wc * 32; const unsigned lo = (unsigned)(fr * ld + 4 * fq) * 2u;
#pragma unroll
    for (int ai = 0; ai < 2; ++ai)
#pragma unroll
      for (int m = 0; m < 4; ++m) {
#pragma unroll
        for (int bj = 0; bj < 2; ++bj)
#pragma unroll
          for (int n = 0; n < 2; ++n) {
            f32x4 v = acc[ai][bj][m][n];
            if (ACT == 1) { v[0] = gelu_tanh(v[0]); v[1] = gelu_tanh(v[1]); v[2] = gelu_tanh(v[2]); v[3] = gelu_tanh(v[3]); }
            if (bj * 128 + wc * 32 + n * 16 < ncols) { u32x2 w; w.x = cvtpk(v[0], v[1]); w.y = cvtpk(v[2], v[3]);
              *(u32x2*)((unsigned char*)(d0 + (size_t)(ai * 128 + m * 16) * ld + bj * 128 + n * 16) + lo) = w; }
          }
      }
  }
};
struct EpiKV {
  bf16_t* kd; bf16_t* vd;
  __device__ __forceinline__ void operator()(Acc& acc, int wr, int wc, int fr, int fq) const {
    bf16_t* k0 = kd + (size_t)(wr * 64) * 1536 + wc * 32; bf16_t* v0 = vd + (size_t)(wr * 64) * 1024 + wc * 32;
    const unsigned lk = (unsigned)(fr * 1536 + 4 * fq) * 2u, lv = (unsigned)(fr * 1024 + 4 * fq) * 2u;
#pragma unroll
    for (int ai = 0; ai < 2; ++ai)
#pragma unroll
      for (int m = 0; m < 4; ++m) {
#pragma unroll
        for (int n = 0; n < 2; ++n) {
          const f32x4 a = acc[ai][0][m][n], b = acc[ai][1][m][n];
          u32x2 w; w.x = cvtpk(a[0], a[1]); w.y = cvtpk(a[2], a[3]); *(u32x2*)((unsigned char*)(k0 + (size_t)(ai * 128 + m * 16) * 1536 + n * 16) + lk) = w;
          w.x = cvtpk(b[0], b[1]); w.y = cvtpk(b[2], b[3]); *(u32x2*)((unsigned char*)(v0 + (size_t)(ai * 128 + m * 16) * 1024 + n * 16) + lv) = w;
        }
      }
  }
};
template <bool PART> struct EpiRes {
  const float* xin; float* xout; const float* gate; int qm;
  __device__ __forceinline__ void operator()(Acc& acc, int wr, int wc, int fr, int fq) const {
    const float* g0 = gate + wc * 32 + 4 * fq;
    const float* xi0 = xin + (size_t)(wr * 64) * D + wc * 32; float* xo0 = xout + (size_t)(wr * 64) * D + wc * 32;
    const unsigned lo = (unsigned)(fr * D + 4 * fq) * 4u;
    f32x4 xa[2][2], xb[2][2], xc[2][2];
#define RES_LD(buf, gi) _Pragma("unroll") for (int bj = 0; bj < 2; ++bj) if (QON((gi) >> 2, bj)) _Pragma("unroll") for (int n = 0; n < 2; ++n) \
      buf[bj][n] = *(const f32x4*)((const char*)(xi0 + (size_t)(((gi) >> 2) * 128 + ((gi) & 3) * 16) * D + bj * 128 + n * 16) + lo)
#define RES_ST(buf, gi) _Pragma("unroll") for (int bj = 0; bj < 2; ++bj) if (QON((gi) >> 2, bj)) _Pragma("unroll") for (int n = 0; n < 2; ++n) \
      *(f32x4*)((char*)(xo0 + (size_t)(((gi) >> 2) * 128 + ((gi) & 3) * 16) * D + bj * 128 + n * 16) + lo) = buf[bj][n] + *(const f32x4*)(g0 + bj * 128 + n * 16) * acc[(gi) >> 2][bj][(gi) & 3][n]
    RES_LD(xa, 0); RES_LD(xb, 1); RES_LD(xc, 2);
    RES_ST(xa, 0); RES_LD(xa, 3);
    RES_ST(xb, 1); RES_LD(xb, 4);
    RES_ST(xc, 2); RES_LD(xc, 5);
    RES_ST(xa, 3); RES_LD(xa, 6);
    RES_ST(xb, 4); RES_LD(xb, 7);
    RES_ST(xc, 5);
    RES_ST(xa, 6);
    RES_ST(xb, 7);
#undef RES_LD
#undef RES_ST
  }
};
template <int BR, bool PART> struct EpiGateR {
  unsigned char* s0; unsigned char* s1; unsigned char* s2; int qm;
  __device__ __forceinline__ void operator()(Acc& acc, int wr, int wc, int fr, int fq) const {
    const unsigned wo = (unsigned)(wr * 4 + wc) * 16384u, lo = (unsigned)(fq * 16 + fr) * 8u;
    unsigned char* cur = (BR == 0 ? s0 : BR == 1 ? s1 : s2) + wo; unsigned char* prv = (BR == 1 ? s0 : s1) + wo;
#pragma unroll
    for (int hf = 0; hf < 4; ++hf) {
      u32x2 pw[8];
      if (BR != 0) {
#pragma unroll
        for (int q = 0; q < 8; ++q) if (QON((hf * 8 + q) >> 4, ((hf * 8 + q) >> 1) & 1)) pw[q] = *(const u32x2*)(prv + (hf * 8 + q) * 512 + lo);
      }
#pragma unroll
      for (int q = 0; q < 8; ++q) {
        const int s = hf * 8 + q, ai = s >> 4, m = (s >> 2) & 3, bj = (s >> 1) & 1, n = s & 1;
        if (!QON(ai, bj)) continue;
        const f32x4 z = acc[ai][bj][m][n]; f32x4 inv, g;
#pragma unroll
        for (int e = 0; e < 4; ++e) { inv[e] = 1.f + __expf(-fminf(fmaxf(z[e], -30.f), 30.f)); g[e] = __builtin_amdgcn_rcpf(inv[e]); }
        u32x2 w; w.x = cvtpk(g[0], g[1]); w.y = cvtpk(g[2], g[3]);
        *(u32x2*)(cur + s * 512 + lo) = w;
        if (BR != 0) { f32x4 r; r[0] = bflo(pw[q].x) * inv[0]; r[1] = bfhi(pw[q].x) * inv[1]; r[2] = bflo(pw[q].y) * inv[2]; r[3] = bfhi(pw[q].y) * inv[3];
          u32x2 o; o.x = cvtpk(r[0], r[1]); o.y = cvtpk(r[2], r[3]); *(u32x2*)(prv + s * 512 + lo) = o; }
      }
    }
  }
};
template <bool LAST, bool PART> struct EpiScale {
  const unsigned char* sl; bf16_t* y; int qm;
  __device__ __forceinline__ void operator()(Acc& acc, int wr, int wc, int fr, int fq) const {
    const unsigned char* wb = sl + (wr * 4 + wc) * 16384; const unsigned lo = (unsigned)(fq * 16 + fr) * 8u;
    bf16_t* yw = y + (size_t)(wr * 64) * D + wc * 32; const unsigned yo = (unsigned)(fr * D + 4 * fq) * 2u;
#pragma unroll
    for (int hf = 0; hf < 4; ++hf) {
      u32x2 pw[8];
#pragma unroll
      for (int q = 0; q < 8; ++q) if (QON((hf * 8 + q) >> 4, ((hf * 8 + q) >> 1) & 1)) pw[q] = *(const u32x2*)(wb + (hf * 8 + q) * 512 + lo);
#pragma unroll
      for (int q = 0; q < 8; ++q) {
        const int s = hf * 8 + q, ai = s >> 4, m = (s >> 2) & 3, bj = (s >> 1) & 1, n = s & 1;
        if (!QON(ai, bj)) continue;
        f32x4 r; r[0] = bflo(pw[q].x); r[1] = bfhi(pw[q].x); r[2] = bflo(pw[q].y); r[3] = bfhi(pw[q].y);
        const f32x4 v = acc[ai][bj][m][n] * r;
        if (!LAST) acc[ai][bj][m][n] = v;
        else { u32x2 o; o.x = cvtpk(v[0], v[1]); o.y = cvtpk(v[2], v[3]);
          *(u32x2*)((unsigned char*)(yw + (size_t)(ai * 128 + m * 16) * D + bj * 128 + n * 16) + yo) = o; }
      }
    }
  }
};
constexpr int CS = 528;
struct EpiConv {
  LAS unsigned char* shm; const float* cw; const float* cb;
  bf16_t* f; int ch0; int nvalid; int hole;
  __device__ __forceinline__ void operator()(Acc& acc, int wr, int wc, int fr, int fq) const {
    int tid = threadIdx.x; asm volatile("" : "+v"(tid)); const int cgp = tid & 15, rg = tid >> 4;
    const int ch = ch0 + cgp * 8;
    float wa[3][8], wv[3][8], ba[8], bv[8];
#pragma unroll
    for (int j = 0; j < 3; ++j)
#pragma unroll
      for (int e = 0; e < 8; e += 4) {
        const f32x4 t0 = *(const f32x4*)(cw + (long)j * F2 + ch + e), t1 = *(const f32x4*)(cw + (long)j * F2 + DFF + ch + e);
        wa[j][e] = t0[0]; wa[j][e + 1] = t0[1]; wa[j][e + 2] = t0[2]; wa[j][e + 3] = t0[3];
        wv[j][e] = t1[0]; wv[j][e + 1] = t1[1]; wv[j][e + 2] = t1[2]; wv[j][e + 3] = t1[3];
      }
#pragma unroll
    for (int e = 0; e < 8; e += 4) {
      const f32x4 t0 = *(const f32x4*)(cb + ch + e), t1 = *(const f32x4*)(cb + DFF + ch + e);
      ba[e] = t0[0]; ba[e + 1] = t0[1]; ba[e + 2] = t0[2]; ba[e + 3] = t0[3];
      bv[e] = t1[0]; bv[e + 1] = t1[1]; bv[e + 2] = t1[2]; bv[e + 3] = t1[3];
    }
#pragma unroll
    for (int ai = 0; ai < 2; ++ai)
#pragma unroll
      for (int m = 0; m < 4; ++m) {
        LAS unsigned char* rp = shm + (ai * 128 + wr * 64 + m * 16 + fr) * CS;
#pragma unroll
        for (int bj = 0; bj < 2; ++bj)
#pragma unroll
          for (int n = 0; n < 2; ++n) {
            const f32x4 v = acc[ai][bj][m][n]; u32x2 w; w.x = cvtpk(v[0], v[1]); w.y = cvtpk(v[2], v[3]);
            *(LAS u32x2*)(rp + (bj * 128 + wc * 32 + n * 16 + 4 * fq) * 2) = w;
          }
      }
    asm volatile("s_waitcnt lgkmcnt(0)" ::: "memory"); __builtin_amdgcn_s_barrier(); asm volatile("" ::: "memory");
    const int R0 = rg * 8;
    float pa[8], ca[8], na[8], pv[8], cv[8], nv[8];
    { const int rp = R0 > 0 ? R0 - 1 : 0;
      unpack8(*(const LAS u32x4*)(shm + rp * CS + cgp * 16), pa); unpack8(*(const LAS u32x4*)(shm + rp * CS + 256 + cgp * 16), pv);
      unpack8(*(const LAS u32x4*)(shm + R0 * CS + cgp * 16), ca); unpack8(*(const LAS u32x4*)(shm + R0 * CS + 256 + cgp * 16), cv); }
#pragma unroll
    for (int i = 0; i < 8; ++i) {
      const int R = R0 + i, rn = R < 255 ? R + 1 : 255;
      unpack8(*(const LAS u32x4*)(shm + rn * CS + cgp * 16), na); unpack8(*(const LAS u32x4*)(shm + rn * CS + 256 + cgp * 16), nv);
      float o[8];
#pragma unroll
      for (int e = 0; e < 8; ++e) {
        const float a = ba[e] + wa[0][e] * pa[e] + wa[1][e] * ca[e] + wa[2][e] * na[e];
        const float v = bv[e] + wv[0][e] * pv[e] + wv[1][e] * cv[e] + wv[2][e] * nv[e];
        o[e] = a * sigmoidf_(a) * v;
      }
      if (R >= 1 && R <= nvalid && !(R >= hole && R < hole + 2)) *(u32x4*)(f + (long)(R - 1 - (R >= hole + 2 ? 2 : 0)) * DFF + ch) = pack8(o);
#pragma unroll
      for (int e = 0; e < 8; ++e) { pa[e] = ca[e]; ca[e] = na[e]; pv[e] = cv[e]; cv[e] = nv[e]; }
    }
    asm volatile("s_waitcnt lgkmcnt(0)" ::: "memory"); __builtin_amdgcn_s_barrier(); asm volatile("" ::: "memory");
  }
};

__device__ __forceinline__ void phase_mod(const P& p, unsigned char* smem) {
  const int tid_ = otid(), bid_ = obid(), grd_ = ogrid(); (void)tid_; (void)bid_; (void)grd_;
  float* s = (float*)smem;
  float* red = s + 3 * 2048;
  const int tid = tid_;
  for (int i = tid; i < 3 * 2048; i += NTHR) { const int r = i >> 11, k = i & 2047; const float v = r < 2 ? p.c[r * 2048 + k] : p.c_ctx[k]; s[i] = v / (1.f + __expf(-v)); }
  __syncthreads();
  float* mod = (float*)(p.ws + OFF_MOD);
  for (int b = bid_; b < 256; b += grd_) {
    const int layer = b >> 7, col0 = (b & 127) * 96, cg4 = tid % 24, ks = tid / 24;
    float a0[4] = {0, 0, 0, 0}, a1[4] = {0, 0, 0, 0}, a2[4] = {0, 0, 0, 0};
    if (ks < 21) {
      const float* wp = p.ada_w + (size_t)layer * 2048 * 12288 + col0 + cg4 * 4;
#pragma unroll 4
      for (int k = ks; k < 2048; k += 21) {
        const f32x4 w = *(const f32x4*)(wp + (size_t)k * 12288);
        const float s0 = s[k], s1 = s[2048 + k], s2 = s[4096 + k];
#pragma unroll
        for (int j = 0; j < 4; ++j) { a0[j] += s0 * w[j]; a1[j] += s1 * w[j]; a2[j] += s2 * w[j]; }
      }
#pragma unroll
      for (int j = 0; j < 4; ++j) { red[(ks * 3 + 0) * 96 + cg4 * 4 + j] = a0[j]; red[(ks * 3 + 1) * 96 + cg4 * 4 + j] = a1[j]; red[(ks * 3 + 2) * 96 + cg4 * 4 + j] = a2[j]; }
    }
    __syncthreads();
    if (tid < 288) {
      const int r = tid / 96, cc = tid % 96; float sum = p.ada_b[layer * 12288 + col0 + cc];
      for (int k = 0; k < 21; ++k) sum += red[(k * 3 + r) * 96 + cc];
      mod[(layer * 3 + r) * 12288 + col0 + cc] = sum;
    }
    __syncthreads();
  }
}

__device__ __forceinline__ void cvt_job(const float* __restrict__ src, int ld_src, int K, int nrows, int colbase, int mode, bf16_t* dst, float* lds, int& rot) {
  const int tid_ = otid(), bid_ = obid(), grd_ = ogrid(); (void)tid_; (void)bid_; (void)grd_;
  const int tid = tid_, ntk = K >> 6, ntiles = (nrows >> 6) * ntk;
  int start = (int)bid_ - rot; if (start < 0) start += grd_;
  for (int t = start; t < ntiles; t += grd_) {
    const int nt = t / ntk, kt = t % ntk, n0 = nt * 64, k0 = kt * 64;
    const int sc0 = mode == 0 ? colbase + n0 : ((n0 >> 8) * 128 + (n0 & 127) + ((n0 >> 7) & 1) * DFF);
    const int kk = tid >> 4, c4 = (tid & 15) * 4;
#pragma unroll
    for (int i = 0; i < 2; ++i) {
      const f32x4 v = *(const f32x4*)(src + (size_t)(k0 + kk + 32 * i) * ld_src + sc0 + c4);
      float* lp = lds + (kk + 32 * i) * 65 + c4; lp[0] = v[0]; lp[1] = v[1]; lp[2] = v[2]; lp[3] = v[3];
    }
    __syncthreads();
    const int n = tid >> 3, kq = (tid & 7) * 8; float f[8];
#pragma unroll
    for (int j = 0; j < 8; ++j) f[j] = lds[(kq + j) * 65 + n];
    *(u32x4*)(dst + (size_t)(n0 + n) * K + k0 + kq) = pack8(f);
    __syncthreads();
  }
  rot = (rot + ntiles) % (int)grd_;
}
__device__ __forceinline__ void phase_cvt(const P& p, int layer, unsigned char* smem) {
  const int tid_ = otid(), bid_ = obid(), grd_ = ogrid(); (void)tid_; (void)bid_; (void)grd_;
  float* lds = (float*)smem; bf16_t* WB = (bf16_t*)(p.ws + OFF_WB); int rot = 0;
  const float* w_in = p.w_in + (size_t)layer * D * INC;
  cvt_job(w_in, INC, D, 1344, 0, 0, WB + W_SM, lds, rot);
  cvt_job(w_in, INC, D, 1024, 1344, 0, WB + W_SM + (size_t)1536 * D, lds, rot);
  cvt_job(w_in, INC, D, 6144, 2368, 0, WB + W_G, lds, rot);
  cvt_job(p.w_uq + (size_t)layer * 512 * 1536, 1536, 512, 1536, 0, 0, WB + W_UQ, lds, rot);
  cvt_job(p.w_ukv + (size_t)layer * 256 * 2048, 2048, 256, 2048, 0, 0, WB + W_UKV, lds, rot);
  for (int g = 0; g < 4; ++g) cvt_job(p.pool_w + ((size_t)layer * 4 + g) * 16384, 128, 128, 128, 0, 0, WB + W_POOL + g * 16384, lds, rot);
  cvt_job(p.w_br_pool + (size_t)layer * 512 * D, D, 512, D, 0, 0, WB + W_BP, lds, rot);
  cvt_job(p.w_br_mla + (size_t)layer * 1024 * D, D, 1024, D, 0, 0, WB + W_BM, lds, rot);
  cvt_job(p.w_br_sg + (size_t)layer * 512 * D, D, 512, D, 0, 0, WB + W_BS, lds, rot);
  cvt_job(p.w_o + (size_t)layer * D * D, D, D, D, 0, 0, WB + W_O, lds, rot);
  cvt_job(p.ffn_up + (size_t)layer * D * F2, F2, D, F2, 0, 1, WB + W_UP, lds, rot);
  cvt_job(p.ffn_down + (size_t)layer * DFF * D, D, DFF, D, 0, 0, WB + W_DN, lds, rot);
  const size_t gt = (size_t)bid_ * NTHR + tid_, gs = (size_t)grd_ * NTHR;
  unsigned zz = 0u; asm volatile("" : "+v"(zz));
  for (size_t i = gt; i < (size_t)192 * D / 8; i += gs) *(u32x4*)(WB + W_SM + (size_t)1344 * D + i * 8) = (u32x4){zz, zz, zz, zz};
  const float* sgw = p.sg_w + (size_t)layer * 65536;
  for (size_t i = gt; i < 65536 / 8; i += gs) { float f[8]; const f32x4 a = *(const f32x4*)(sgw + i * 8), b = *(const f32x4*)(sgw + i * 8 + 4);
    f[0] = a[0]; f[1] = a[1]; f[2] = a[2]; f[3] = a[3]; f[4] = b[0]; f[5] = b[1]; f[6] = b[2]; f[7] = b[3]; *(u32x4*)(WB + W_SG + i * 8) = pack8(f); }
}

__device__ __forceinline__ void phase_norm(const float* xlat, const float* xctx, const float* g, const float* modl, int shc, int scc, bf16_t* H, bool padded, int nrows) {
  const int tid_ = otid(), bid_ = obid(), grd_ = ogrid(); (void)tid_; (void)bid_; (void)grd_;
  const int lane = tid_ & 63, gw = bid_ * 8 + (tid_ >> 6), nw = grd_ * 8;
  for (int r = gw; r < nrows; r += nw) {
    const float* src = r < NLAT ? xlat + (size_t)r * D : xctx + (size_t)(r - NLAT) * D;
    const float* mr = modl + mod_row(r) * 12288;
    float xv[32]; float ss = 0.f;
#pragma unroll
    for (int j = 0; j < 4; ++j) {
      const f32x4 a = *(const f32x4*)(src + j * 512 + lane * 8), b = *(const f32x4*)(src + j * 512 + lane * 8 + 4);
#pragma unroll
      for (int e = 0; e < 4; ++e) { xv[j * 8 + e] = a[e]; xv[j * 8 + 4 + e] = b[e]; ss += a[e] * a[e] + b[e] * b[e]; }
    }
    ss = wave_sum(ss);
    const float rr = rsqrtf(ss * (1.f / D) + EPS);
    size_t drow;
    if (!padded) drow = r;
    else drow = r < NLAT ? (size_t)(r >> 14) * HP_LAT + 1 + (r & (SEQ - 1)) : (size_t)HP_CTX0 + ((r - NLAT) >> 8) * HP_CTX + 1 + ((r - NLAT) & 255);
#pragma unroll
    for (int j = 0; j < 4; ++j) {
      const int c = j * 512 + lane * 8; float o[8];
#pragma unroll
      for (int e = 0; e < 8; e += 4) {
        const f32x4 gg = *(const f32x4*)(g + c + e), sh = *(const f32x4*)(mr + shc * 2048 + c + e), sc = *(const f32x4*)(mr + scc * 2048 + c + e);
#pragma unroll
        for (int q = 0; q < 4; ++q) o[e + q] = xv[j * 8 + e + q] * rr * gg[q] * (1.f + sc[q]) + sh[q];
      }
      *(u32x4*)(H + drow * D + c) = pack8(o);
    }
  }
  if (padded && bid_ == 0) {
    const int tid = tid_;
    for (int i = tid; i < 8 * (D / 8); i += NTHR) {
      const int z = i / (D / 8), c = (i % (D / 8)) * 8;
      const size_t row = z < 4 ? (size_t)(z >> 1) * HP_LAT + (z & 1) * (SEQ + 1) : (size_t)HP_CTX0 + ((z - 4) >> 1) * HP_CTX + (z & 1) * (CTX + 1);
      unsigned zz = 0u; asm volatile("" : "+v"(zz));
      *(u32x4*)(H + row * D + c) = (u32x4){zz, zz, zz, zz};
    }
  }
}

__device__ __forceinline__ void phase_prep(const P& p, int layer, unsigned char* smem) {
  const int tid_ = otid(), bid_ = obid(), grd_ = ogrid(); (void)tid_; (void)bid_; (void)grd_;
  bf16_t* ACT = (bf16_t*)(p.ws + OFF_ACT);
  const int lane = tid_ & 63, wv = tid_ >> 6, gw = bid_ * 8 + wv, nw = grd_ * 8;
  float gq[8], gkv[4];
#pragma unroll
  for (int e = 0; e < 8; ++e) gq[e] = p.q_lat_g[layer * 512 + lane * 8 + e];
#pragma unroll
  for (int e = 0; e < 4; ++e) gkv[e] = p.kv_lat_g[layer * 256 + lane * 4 + e];
  for (int r = gw; r < MT; r += nw) {
    { const int s0 = r < NLAT ? (r & ~(SEQ - 1)) : NLAT + ((r - NLAT) & ~255), Ls = r < NLAT ? SEQ : CTX, t = r - s0;
      const int half = 1 << (lane >> 4); const int lo = max(t - half, 0), hi = min(t + half, Ls);
      float sum[8] = {0, 0, 0, 0, 0, 0, 0, 0}, zc[8];
      u32x4 wv_[16];
#pragma unroll
      for (int i = 0; i < 16; ++i) { const int tt = min(lo + i, hi - 1); wv_[i] = *(const u32x4*)(ACT + A_ZPOOL + (size_t)(s0 + tt) * 512 + lane * 8); }
#pragma unroll
      for (int i = 0; i < 16; ++i) { float f[8]; unpack8(wv_[i], f); const float on = (lo + i < hi) ? 1.f : 0.f;
#pragma unroll
        for (int e = 0; e < 8; ++e) sum[e] += on * f[e]; }
      unpack8(*(const u32x4*)(ACT + A_ZPOOL + (size_t)r * 512 + lane * 8), zc);
      const float ic = 1.f / (float)(hi - lo);
#pragma unroll
      for (int e = 0; e < 8; ++e) sum[e] = sum[e] * ic - zc[e];
      *(u32x4*)(ACT + A_POOLED + (size_t)r * 512 + lane * 8) = pack8(sum); }
    { float f[8]; bf16_t* zp = ACT + A_ZQ + (size_t)r * 512 + lane * 8; unpack8(*(const u32x4*)zp, f); float ss = 0.f;
#pragma unroll
      for (int e = 0; e < 8; ++e) ss += f[e] * f[e];
      ss = wave_sum(ss); const float rr = rsqrtf(ss * (1.f / 512) + EPS);
#pragma unroll
      for (int e = 0; e < 8; ++e) f[e] = f[e] * rr * gq[e];
      *(u32x4*)zp = pack8(f); }
    { bf16_t* zp = ACT + A_ZKV + (size_t)r * 256 + lane * 4; const u32x2 w = *(const u32x2*)zp;
      float f0 = bflo(w.x), f1 = bfhi(w.x), f2 = bflo(w.y), f3 = bfhi(w.y);
      float ss = wave_sum(f0 * f0 + f1 * f1 + f2 * f2 + f3 * f3); const float rr = rsqrtf(ss * (1.f / 256) + EPS);
      u32x2 o; o.x = cvtpk(f0 * rr * gkv[0], f1 * rr * gkv[1]); o.y = cvtpk(f2 * rr * gkv[2], f3 * rr * gkv[3]); *(u32x2*)zp = o; }
  }
  float gs8[8];
#pragma unroll
  for (int e = 0; e < 8; ++e) gs8[e] = p.sg_norm_g[layer * 512 + lane * 8 + e];
  for (int ci = bid_; ci < MT / 128; ci += grd_) {
    bf16_t* base = ACT + A_VG + (size_t)ci * 65536;
    for (int q = wv * 16; q < wv * 16 + 16; ++q) {
      float f[8]; unpack8(*(const u32x4*)(base + (size_t)q * 512 + lane * 8), f);
      float s = 0.f;
#pragma unroll
      for (int e = 0; e < 8; ++e) s += f[e];
      const float mean = wave_sum(s) * (1.f / 512); float v = 0.f;
#pragma unroll
      for (int e = 0; e < 8; ++e) { f[e] -= mean; v += f[e] * f[e]; }
      const float rs = rsqrtf(wave_sum(v) * (1.f / 512) + EPS);
#pragma unroll
      for (int e = 0; e < 8; e += 2) { const unsigned w = cvtpk(f[e] * rs * gs8[e], f[e + 1] * rs * gs8[e + 1]);
        *(bf16_t*)(smem + ((lane * 8 + e) * 130 + q) * 2) = (bf16_t)(w & 0xffff); *(bf16_t*)(smem + ((lane * 8 + e + 1) * 130 + q) * 2) = (bf16_t)(w >> 16); }
    }
    __syncthreads();
    for (int i = tid_; i < 8192; i += NTHR) {
      const int ch = i >> 4, q0 = (i & 15) * 8; const unsigned* lp = (const unsigned*)(smem + (ch * 130 + q0) * 2);
      u32x4 w; w.x = lp[0]; w.y = lp[1]; w.z = lp[2]; w.w = lp[3];
      *(u32x4*)(base + (size_t)ch * 128 + q0) = w;
    }
    __syncthreads();
  }
}

template <class F>
__device__ __forceinline__ void small_gemm(const bf16_t* A, long lda, const bf16_t* Bt, long ldb, int fr, int fq, F epi) {
  bf16x8 a[2][4];
#pragma unroll
  for (int mi = 0; mi < 2; ++mi)
#pragma unroll
    for (int ks = 0; ks < 4; ++ks) a[mi][ks] = *(const bf16x8*)(A + (long)(mi * 16 + fr) * lda + ks * 32 + fq * 8);
#pragma unroll 2
  for (int nj = 0; nj < 8; ++nj) {
    bf16x8 b[4];
#pragma unroll
    for (int ks = 0; ks < 4; ++ks) b[ks] = *(const bf16x8*)(Bt + (long)(nj * 16 + fr) * ldb + ks * 32 + fq * 8);
#pragma unroll
    for (int mi = 0; mi < 2; ++mi) {
      f32x4 c = {0.f, 0.f, 0.f, 0.f};
#pragma unroll
      for (int ks = 0; ks < 4; ++ks) c = __builtin_amdgcn_mfma_f32_16x16x32_bf16(b[ks], a[mi][ks], c, 0, 0, 0);
      epi(mi, nj, c);
    }
  }
}
__device__ __forceinline__ void phase_small(const P& p, int layer) {
  const int tid_ = otid(), bid_ = obid(), grd_ = ogrid(); (void)tid_; (void)bid_; (void)grd_;
  bf16_t* ACT = (bf16_t*)(p.ws + OFF_ACT); const bf16_t* WB = (const bf16_t*)(p.ws + OFF_WB);
  const int lane = tid_ & 63, fr = lane & 15, fq = lane >> 4, gw = bid_ * 8 + (tid_ >> 6), nw = grd_ * 8;
#pragma unroll 1
  for (int it = gw; it < (MT / 32) * 4; it += nw) {
    const int g = it & 3, r0 = (it >> 2) * 32;
    const float* psc = p.pool_scale + layer * 512 + g * 128 + 4 * fq; bf16_t* op = ACT + A_ZPOOL + (size_t)(r0 + fr) * 512 + g * 128 + 4 * fq;
    small_gemm(ACT + A_POOLED + (size_t)r0 * 512 + g * 128, 512, WB + W_POOL + g * 16384, 128, fr, fq, [&](int mi, int nj, f32x4 c) {
      const f32x4 v = c * *(const f32x4*)(psc + nj * 16); u32x2 w; w.x = cvtpk(v[0], v[1]); w.y = cvtpk(v[2], v[3]);
      *(u32x2*)(op + (size_t)mi * 16 * 512 + nj * 16) = w; });
  }
#pragma unroll 1
  for (int it = gw; it < (MT / 128) * 16; it += nw) {
    const int pb = it & 3, g = (it >> 2) & 3, ci = it >> 4;
    const float* bp = p.sg_b + (layer * 4 + g) * 128 + pb * 32 + fr; bf16_t* up = ACT + A_U + (size_t)(ci * 128 + pb * 32 + fr) * 512 + g * 128 + 4 * fq;
    const float bb0 = bp[0], bb1 = bp[16];
    small_gemm(WB + W_SG + g * 16384 + pb * 32 * 128, 128, ACT + A_VG + (size_t)ci * 65536 + g * 16384, 128, fr, fq, [&](int mi, int nj, f32x4 s) {
      const float bb = mi ? bb1 : bb0; bf16_t* q = up + (size_t)mi * 16 * 512 + nj * 16; const u32x2 uw = *(const u32x2*)q;
      u32x2 w; w.x = cvtpk(bflo(uw.x) * (s[0] + bb), bfhi(uw.x) * (s[1] + bb)); w.y = cvtpk(bflo(uw.y) * (s[2] + bb), bfhi(uw.y) * (s[3] + bb));
      *(u32x2*)q = w; });
  }
}

__device__ __forceinline__ void rope8(float* y, int j, int t, bool on) {
  if (!on) return;
  const int axis = j >> 2, half = (j >> 1) & 1; const float pos = (float)(axis ? (t & 63) : (t >> 6));
#pragma unroll
  for (int e = 0; e < 8; ++e) {
    const int f = (j & 1) * 8 + e;
    const float rev = pos * (exp2f(-0.8304820237218406f * (float)f) * 0.15915494309189535f);
    const float sn = __builtin_amdgcn_sinf(rev), cs = __builtin_amdgcn_cosf(rev);
    const float pr = __shfl_xor(y[e], 2);
    y[e] = half ? y[e] * cs + pr * sn : y[e] * cs - pr * sn;
  }
}
__device__ __forceinline__ void phase_qk(const P& p, int layer) {
  const int tid_ = otid(), bid_ = obid(), grd_ = ogrid(); (void)tid_; (void)bid_; (void)grd_;
  bf16_t* ACT = (bf16_t*)(p.ws + OFF_ACT);
  const int lane = tid_ & 63, h = lane >> 3, j = lane & 7, gw = bid_ * 8 + (tid_ >> 6), nw = grd_ * 8;
  float qg[3][8], kg[3][8];
#pragma unroll
  for (int i = 0; i < 3; ++i)
#pragma unroll
    for (int e = 0; e < 8; ++e) { qg[i][e] = p.q_norm_g[layer * 192 + i * 64 + j * 8 + e]; kg[i][e] = p.k_norm_g[layer * 192 + i * 64 + j * 8 + e]; }
  for (int r = gw; r < MT; r += nw) {
    const bool lat = r < NLAT; const int t = r & (SEQ - 1);
    if (lat || layer == 0) {
      bf16_t* qp = ACT + A_Q + (size_t)r * 1536 + h * 192 + j * 8; float y[3][8]; float ss = 0.f;
#pragma unroll
      for (int i = 0; i < 3; ++i) { unpack8(*(const u32x4*)(qp + i * 64), y[i]);
#pragma unroll
        for (int e = 0; e < 8; ++e) ss += y[i][e] * y[i][e]; }
      ss += __shfl_xor(ss, 1); ss += __shfl_xor(ss, 2); ss += __shfl_xor(ss, 4);
      const float rr = rsqrtf(ss * (1.f / 192) + EPS);
#pragma unroll
      for (int i = 0; i < 3; ++i)
#pragma unroll
        for (int e = 0; e < 8; ++e) y[i][e] *= rr * qg[i][e];
      rope8(y[2], j, t, lat);
#pragma unroll
      for (int i = 0; i < 3; ++i) *(u32x4*)(qp + i * 64) = pack8(y[i]);
    }
    {
      bf16_t* kp = ACT + A_K + (size_t)kv_row(r) * 1536 + h * 192 + j * 8; float y[3][8]; float ss = 0.f;
      unpack8(*(const u32x4*)(kp), y[0]); unpack8(*(const u32x4*)(kp + 64), y[1]); unpack8(*(const u32x4*)(ACT + A_ZKR + (size_t)r * 64 + j * 8), y[2]);
#pragma unroll
      for (int i = 0; i < 3; ++i)
#pragma unroll
        for (int e = 0; e < 8; ++e) ss += y[i][e] * y[i][e];
      ss += __shfl_xor(ss, 1); ss += __shfl_xor(ss, 2); ss += __shfl_xor(ss, 4);
      const float rr = rsqrtf(ss * (1.f / 192) + EPS);
#pragma unroll
      for (int i = 0; i < 3; ++i)
#pragma unroll
        for (int e = 0; e < 8; ++e) y[i][e] *= rr * kg[i][e];
      rope8(y[2], j, t, lat);
#pragma unroll
      for (int i = 0; i < 3; ++i) *(u32x4*)(kp + i * 64) = pack8(y[i]);
    }
  }
}

constexpr int LDQ = 1536, LDK = 1536, LDV = 1024, LDO = 1024;
constexpr float ASCALE = 0.07216878364870322f;
constexpr float ATHR = 8.f;
constexpr int SHM_V = 64 * 128 * 2, SHM_K = 64 * 192 * 2;
#define KADDR(row, ch24) (((ch24) >> 3) * 8192 + (row) * 128 + (((((ch24) & 7)) ^ (((row) >> 1) & 7)) << 4))
#define SBAR() __builtin_amdgcn_sched_barrier(0)
__device__ __forceinline__ int crow(int r, int hi) { return (r & 3) + 8 * (r >> 2) + 4 * hi; }
__device__ __forceinline__ void partialSM(f32x16& p0, f32x16& p1, float& m_reg, float& mn, float& alpha) {
  constexpr float C = ASCALE * 1.4426950408889634f;
  float pmax = p0[0];
#pragma unroll
  for (int r = 1; r < 16; ++r) pmax = fmaxf(pmax, p0[r]);
#pragma unroll
  for (int r = 0; r < 16; ++r) pmax = fmaxf(pmax, p1[r]);
  { auto rr = __builtin_amdgcn_permlane32_swap(__float_as_uint(pmax), __float_as_uint(pmax), false, false);
    pmax = fmaxf(__uint_as_float(rr[0]), __uint_as_float(rr[1])); }
  if (__builtin_expect(__all(pmax - m_reg <= ATHR / ASCALE), 1)) { mn = m_reg; alpha = 1.f; }
  else { mn = fmaxf(m_reg, pmax); alpha = __builtin_amdgcn_exp2f((m_reg - mn) * C); m_reg = mn; }
  const float mnC = -mn * C;
#pragma unroll
  for (int r = 0; r < 16; ++r) p0[r] = fmaf(p0[r], C, mnC);
#pragma unroll
  for (int r = 0; r < 16; ++r) p1[r] = fmaf(p1[r], C, mnC);
#pragma unroll
  for (int r = 0; r < 16; ++r) p0[r] = __builtin_amdgcn_exp2f(p0[r]);
}
__device__ __forceinline__ void finishSM(f32x16& p0, f32x16& p1, float alpha, float& l_reg, bf16x8& pa0, bf16x8& pa1, bf16x8& pa2, bf16x8& pa3) {
#pragma unroll
  for (int r = 0; r < 16; ++r) p1[r] = __builtin_amdgcn_exp2f(p1[r]);
  float ps = 0;
#pragma unroll
  for (int r = 0; r < 16; ++r) ps += p0[r];
#pragma unroll
  for (int r = 0; r < 16; ++r) ps += p1[r];
  { auto rr = __builtin_amdgcn_permlane32_swap(__float_as_uint(ps), __float_as_uint(ps), false, false);
    ps = __uint_as_float(rr[0]) + __uint_as_float(rr[1]); }
  l_reg = l_reg * alpha + ps;
#define PK4(Pv, BASE, OUT) do { unsigned a0 = cvtpk(Pv[BASE + 0], Pv[BASE + 1]), a1 = cvtpk(Pv[BASE + 2], Pv[BASE + 3]);   \
    unsigned b0 = cvtpk(Pv[BASE + 4], Pv[BASE + 5]), b1 = cvtpk(Pv[BASE + 6], Pv[BASE + 7]);                              \
    auto r0 = __builtin_amdgcn_permlane32_swap(a0, b0, false, false); auto r1 = __builtin_amdgcn_permlane32_swap(a1, b1, false, false); \
    u32x4 w = {r0[0], r1[0], r0[1], r1[1]}; OUT = *reinterpret_cast<bf16x8*>(&w); } while (0)
  PK4(p0, 0, pa0); PK4(p0, 8, pa1); PK4(p1, 0, pa2); PK4(p1, 8, pa3);
#undef PK4
}
__device__ __forceinline__ void qkt(f32x16& p0, f32x16& p1, const LAS unsigned char* Ks, const bf16x8* qr, const int* kb) {
  p0 = f32x16{}; p1 = f32x16{};
#pragma unroll
  for (int d0 = 0; d0 < 12; ++d0) {
    const bf16x8 b0 = *(const LAS bf16x8*)(Ks + kb[d0 & 3] + (d0 >> 2) * 8192);
    const bf16x8 b1 = *(const LAS bf16x8*)(Ks + kb[d0 & 3] + (d0 >> 2) * 8192 + 4096);
    p0 = __builtin_amdgcn_mfma_f32_32x32x16_bf16(b0, qr[d0], p0, 0, 0, 0);
    p1 = __builtin_amdgcn_mfma_f32_32x32x16_bf16(b1, qr[d0], p1, 0, 0, 0); }
}
__device__ __forceinline__ int v_st(int k, int c) { const int kk = (k & ~0xC) | ((k & 4) << 1) | ((k & 8) >> 1); return ((kk >> 3) * 4 + (c >> 5)) * 512 + ((kk & 7) * 32 + (c & 31)) * 2; }
__device__ __forceinline__ int v_rd_base(int lane) { return ((lane & 3) << 3) | (((lane >> 2) & 3) << 6) | (((lane >> 4) & 1) << 5) | (((lane >> 5) & 1) << 8); }
constexpr int v_rd_off(int d0, int ks, int half) { return d0 * 512 + ks * 4096 + half * 2048; }
template <int OFF> __device__ __forceinline__ s16x4 tr_read(int vb) {
  s16x4 r; asm volatile("ds_read_b64_tr_b16 %0, %1 offset:%2" : "=&v"(r) : "v"(vb), "i"(OFF) : "memory"); return r;
}
template <int D0> __device__ __forceinline__ void pv_one(f32x16& od, int vb, bf16x8 pa0, bf16x8 pa1, bf16x8 pa2, bf16x8 pa3) {
  const s16x4 l0 = tr_read<v_rd_off(D0, 0, 0)>(vb), h0 = tr_read<v_rd_off(D0, 0, 1)>(vb), l1 = tr_read<v_rd_off(D0, 1, 0)>(vb), h1 = tr_read<v_rd_off(D0, 1, 1)>(vb);
  const s16x4 l2 = tr_read<v_rd_off(D0, 2, 0)>(vb), h2 = tr_read<v_rd_off(D0, 2, 1)>(vb), l3 = tr_read<v_rd_off(D0, 3, 0)>(vb), h3 = tr_read<v_rd_off(D0, 3, 1)>(vb);
  asm volatile("s_waitcnt lgkmcnt(0)" ::: "memory"); SBAR();
#define PKV(Lo, Hi) (bf16x8){Lo[0], Lo[1], Lo[2], Lo[3], Hi[0], Hi[1], Hi[2], Hi[3]}
  od = __builtin_amdgcn_mfma_f32_32x32x16_bf16(pa0, PKV(l0, h0), od, 0, 0, 0);
  od = __builtin_amdgcn_mfma_f32_32x32x16_bf16(pa1, PKV(l1, h1), od, 0, 0, 0);
  od = __builtin_amdgcn_mfma_f32_32x32x16_bf16(pa2, PKV(l2, h2), od, 0, 0, 0);
  od = __builtin_amdgcn_mfma_f32_32x32x16_bf16(pa3, PKV(l3, h3), od, 0, 0, 0);
#undef PKV
}
__device__ __forceinline__ void pv_d0(f32x16* o, int vb, bf16x8 pa0, bf16x8 pa1, bf16x8 pa2, bf16x8 pa3) {
  pv_one<0>(o[0], vb, pa0, pa1, pa2, pa3); pv_one<1>(o[1], vb, pa0, pa1, pa2, pa3); pv_one<2>(o[2], vb, pa0, pa1, pa2, pa3); pv_one<3>(o[3], vb, pa0, pa1, pa2, pa3);
}
__device__ __forceinline__ void attn_unit(const bf16_t* Qb, const bf16_t* Kh, const bf16_t* Vh, bf16_t* Ob, int seq, LAS unsigned char* lds) {
  const int tid_ = otid(), bid_ = obid(), grd_ = ogrid(); (void)tid_; (void)bid_; (void)grd_;
  const int tid = tid_, wid = __builtin_amdgcn_readfirstlane(tid >> 6), lane = tid & 63, r32 = lane & 31, hi = lane >> 5;
  LAS unsigned char* V_lds = lds; LAS unsigned char* K_lds = lds + 2 * SHM_V;
  LAS float* wsl = (LAS float*)(lds + 2 * SHM_V + 2 * SHM_K) + wid * 64; LAS float* li_l = wsl; LAS float* al_l = wsl + 32;
  float m_reg = -1e30f, l_reg = 0; f32x16 o[4] = {}; bf16x8 qr[12];
  { const bf16_t* Qw = Qb + (size_t)(wid * 32) * LDQ; const unsigned qo = (unsigned)(r32 * LDQ + hi * 8) * 2u;
#pragma unroll
    for (int d0 = 0; d0 < 12; ++d0) qr[d0] = *(const bf16x8*)((const char*)Qw + qo + d0 * 32); }
  unsigned kgo[3], vgo[2];
#pragma unroll
  for (int i = 0; i < 3; ++i) { const int pu = (i * 8 + wid) * 64 + lane, sub = pu >> 9, row = (pu >> 3) & 63, pc = pu & 7, cch = pc ^ ((row >> 1) & 7);
    kgo[i] = (unsigned)(row * LDK + (sub * 8 + cch) * 8) * 2u; }
#pragma unroll
  for (int i = 0; i < 2; ++i) { const int u = (i * 8 + wid) * 64 + lane, st = u >> 5, kk = ((st >> 2) << 3) | ((u >> 2) & 7), cc = ((st & 3) << 5) | ((u & 3) << 3);
    const int k = (kk & ~0xC) | ((kk & 4) << 1) | ((kk & 8) >> 1); vgo[i] = (unsigned)(k * LDV + cc) * 2u; }
  int kb[4];
#pragma unroll
  for (int q = 0; q < 4; ++q) kb[q] = r32 * 128 + (((q * 2 + hi) ^ ((r32 >> 1) & 7)) << 4);
  const int vb0 = (int)(uintptr_t)V_lds + v_rd_base(lane);
  const char* Kt = (const char*)Kh; const char* Vt = (const char*)Vh;
#define DMA(b) do { \
    _Pragma("unroll") for (int _i = 0; _i < 3; ++_i) __builtin_amdgcn_global_load_lds((const unsigned*)(Kt + kgo[_i]), (LAS unsigned*)(K_lds + (b) * SHM_K + (_i * 8 + wid) * 1024), 16, 0, 0); \
    _Pragma("unroll") for (int _i = 0; _i < 2; ++_i) __builtin_amdgcn_global_load_lds((const unsigned*)(Vt + vgo[_i]), (LAS unsigned*)(V_lds + (b) * SHM_V + (_i * 8 + wid) * 1024), 16, 0, 0); \
    Kt += 64 * LDK * 2; Vt += 64 * LDV * 2; } while (0)
#define VMW() asm volatile("s_waitcnt vmcnt(0)" ::: "memory")
#define RESC(a) do { if (__any((a) < 1.f)) { if (hi == 0) al_l[r32] = (a); asm volatile("s_waitcnt lgkmcnt(0)" ::: "memory"); \
    _Pragma("unroll") for (int d = 0; d < 4; ++d) _Pragma("unroll") for (int r = 0; r < 16; ++r) o[d][r] *= al_l[crow(r, hi)]; } } while (0)
  f32x16 pA0, pA1; float mnA, alA; bf16x8 pa0, pa1, pa2, pa3; const int NT = seq / 64;
  DMA(0); VMW(); __syncthreads();
  for (int j = 0; j < NT; j += 2) {
    DMA(1); SBAR();
    qkt(pA0, pA1, K_lds, qr, kb); partialSM(pA0, pA1, m_reg, mnA, alA);
    finishSM(pA0, pA1, alA, l_reg, pa0, pa1, pa2, pa3); RESC(alA); SBAR();
    pv_d0(o, vb0, pa0, pa1, pa2, pa3);
    VMW(); __syncthreads();
    if (j + 2 < NT) DMA(0); SBAR();
    qkt(pA0, pA1, K_lds + SHM_K, qr, kb); partialSM(pA0, pA1, m_reg, mnA, alA);
    finishSM(pA0, pA1, alA, l_reg, pa0, pa1, pa2, pa3); RESC(alA); SBAR();
    pv_d0(o, vb0 + SHM_V, pa0, pa1, pa2, pa3);
    VMW(); __syncthreads();
  }
  if (hi == 0) li_l[r32] = l_reg; asm volatile("s_waitcnt lgkmcnt(0)" ::: "memory");
  bf16_t* Ow = Ob + (size_t)(wid * 32) * LDO;
#pragma unroll
  for (int r = 0; r < 16; ++r) { const int orow = crow(r, hi); const float rl = __builtin_amdgcn_rcpf(li_l[orow]);
#pragma unroll
    for (int d0 = 0; d0 < 4; ++d0) Ow[orow * LDO + d0 * 32 + r32] = (bf16_t)(cvtpk(o[d0][r] * rl, 0.f) & 0xffff); }
  __syncthreads();
#undef DMA
#undef VMW
#undef RESC
}
__device__ __forceinline__ void phase_attn(const P& p, int layer, unsigned char* smem) {
  const int tid_ = otid(), bid_ = obid(), grd_ = ogrid(); (void)tid_; (void)bid_; (void)grd_;
  bf16_t* ACT = (bf16_t*)(p.ws + OFF_ACT);
  const int G = grd_, c = bid_;
  for (int u = c; u < 1024; u += G) {
    int bh, qb;
    if (G == 256) { const int i = u >> 8, x = c & 7, j = c >> 3; bh = i * 4 + (x >> 1); qb = (x & 1) * 32 + j; } else { bh = u >> 6; qb = u & 63; }
    const int b = bh >> 3, h = bh & 7; const size_t qrow = (size_t)b * SEQ + qb * 256, krow = (size_t)b * KVS;
    attn_unit(ACT + A_Q + qrow * LDQ + h * 192, ACT + A_K + krow * LDK + h * 192, ACT + A_V + krow * LDV + h * 128, ACT + A_ATT + qrow * LDO + h * 128, KVS, (LAS unsigned char*)smem);
  }
  if (layer == 0) for (int u = c; u < 16; u += G) {
    const int b = u >> 3, h = u & 7; const size_t qrow = (size_t)NLAT + b * CTX, krow = (size_t)b * KVS + SEQ;
    attn_unit(ACT + A_Q + qrow * LDQ + h * 192, ACT + A_K + krow * LDK + h * 192, ACT + A_V + krow * LDV + h * 128, ACT + A_ATT + qrow * LDO + h * 128, CTX, (LAS unsigned char*)smem);
  }
}

#ifndef TESTMASK
#define TESTMASK 0xFFFF
#endif
#define RUNPH(n) ((TESTMASK >> (n)) & 1)
template <unsigned MASK = 0x3fffffffu>
__device__ __forceinline__ P load_params() {
  P r{}; const volatile __attribute__((address_space(4))) unsigned long long* kp = (const volatile __attribute__((address_space(4))) unsigned long long*)__builtin_amdgcn_kernarg_segment_ptr();
  const float** d = (const float**)&r;
#pragma unroll
  for (int i = 0; i < 30; ++i) if ((MASK >> i) & 1u) d[i] = (const float*)(const __attribute__((address_space(1))) float*)kp[i];
  return r;
}
constexpr unsigned M_WS = 1u << 29, M_OUT = 1u << 28, M_IO = M_WS | M_OUT | 1u | (1u << 2);
__device__ __forceinline__ int opq(int v) { asm volatile("" : "+s"(v)); return v; }
#define ENV() const int G = ogrid(), c = obid(); (void)G; (void)c; const P p = load_params<M_IO | (1u << 6) | (1u << 23) | (1u << 25) | (1u << 26)>(); bf16_t* ACT = (bf16_t*)(p.ws + OFF_ACT); const bf16_t* WB = (const bf16_t*)(p.ws + OFF_WB); bf16_t* H = (bf16_t*)(p.ws + OFF_H); \
  float* XC = (float*)(p.ws + OFF_XC); const float* modl = (const float*)(p.ws + OFF_MOD) + layer * 3 * 12288; \
  const float* xlat = layer ? p.out : p.x; const float* xctx = layer ? XC : p.ctx; (void)ACT; (void)WB; (void)H; (void)XC; (void)modl; (void)xlat; (void)xctx;

#ifndef DBG_MERGE
#define DBG_MERGE 0
#endif
#ifndef DBG_STOP
#define DBG_STOP 0
#endif
__device__ __forceinline__ void dbg_dump(const bf16_t* src, size_t nelem, const bf16_t* src2 = nullptr, size_t nelem2 = 1) {
  const P p = load_params<M_OUT>(); const size_t n = (size_t)NLAT * D;
  for (size_t i = (size_t)blockIdx.x * NTHR + threadIdx.x; i < n; i += (size_t)gridDim.x * NTHR)
    p.out[i] = (src2 && i >= n / 2) ? bflo((unsigned)src2[(i - n / 2) % nelem2]) : bflo((unsigned)src[i % nelem]);
}
#define DBG(k, off, ne) if (DBG_STOP == (k) && layer == 0) { dbg_dump((const bf16_t*)(load_params<M_WS>().ws + OFF_ACT) + (off), (ne)); return; }
__global__ void __launch_bounds__(NTHR, 2) mega(P p_arg) {
  extern __shared__ __attribute__((aligned(16))) unsigned char smem[];
  cg::grid_group grid = cg::this_grid();
  unsigned nbar = 0;
#define GSYNC() do { ++nbar; grid_barrier((unsigned*)(load_params<M_WS>().ws + OFF_CTL), nbar * gridDim.x); } while (0)
  LAS unsigned char* lds3 = (LAS unsigned char*)smem;

  grid.sync();
  if (RUNPH(0)) { const P p = load_params(); phase_mod(p, smem); phase_cvt(p, 0, smem); }
  GSYNC();

#pragma unroll 1
  for (int layer = 0; layer < 2; ++layer) {
    const int nMr = layer == 0 ? 130 : 128;
    if (RUNPH(0)) if (layer == 1) { const P p = load_params(); phase_cvt(p, 1, smem); }
    if (RUNPH(1)) { ENV(); phase_norm(xlat, xctx, p.norm1_g + layer * D, modl, 0, 1, H, false, MT); }
    GSYNC();
    if (DBG_STOP == 8 && layer == 0) { dbg_dump((const bf16_t*)(load_params<M_WS>().ws + OFF_WB), W_END); return; }
    if (DBG_STOP == 9 && layer == 0) { dbg_dump((const bf16_t*)(load_params<M_WS>().ws + OFF_H), (size_t)MT * D); return; }
    if (RUNPH(2)) { ENV();
#pragma unroll 1
      for (int L = c; L < 130 * 10; L += G) {
        int pm, pn; tile_order(L, 130, 10, pm, pn); pm = opq(pm); pn = opq(pn);
        bf16_t* dst; unsigned ld; int ncols = 256, act = 0;
        if (pn < 2) { dst = ACT + A_ZPOOL + (size_t)pm * 256 * 512 + pn * 256; ld = 512; }
        else if (pn < 4) { dst = ACT + A_ZQ + (size_t)pm * 256 * 512 + (pn - 2) * 256; ld = 512; }
        else if (pn == 4) { dst = ACT + A_ZKV + (size_t)pm * 256 * 256; ld = 256; }
        else if (pn == 5) { dst = ACT + A_ZKR + (size_t)pm * 256 * 64; ld = 64; ncols = 64; }
        else if (pn < 8) { dst = ACT + A_U + (size_t)pm * 256 * 512 + (pn - 6) * 256; ld = 512; act = 1; }
        else { dst = ACT + A_VG + (size_t)pm * 256 * 512 + (pn - 8) * 256; ld = 512; act = 1; }
        const bf16_t* Ap = H + (size_t)pm * 256 * D; const bf16_t* Bp = WB + W_SM + (size_t)pn * 256 * D;
        if (act) gemm_tile(Ap, D, Bp, D, D, lds3, EpiBf16<1>{dst, ld, ncols});
        else gemm_tile(Ap, D, Bp, D, D, lds3, EpiBf16<0>{dst, ld, ncols});
      } }
    GSYNC();
    DBG(1, A_ZQ, (size_t)MT * 512)
    if (RUNPH(3)) { const P p = load_params<M_WS | (1u << 10) | (1u << 12) | (1u << 16)>(); phase_prep(p, layer, smem); }
    GSYNC();
    if (RUNPH(4)) { ENV();
#pragma unroll 1
      for (int L = c; L < nMr * 6; L += G) {
        int pm, pn; tile_order(L, nMr, 6, pm, pn); pm = opq(pm); pn = opq(pn);
        gemm_tile(ACT + A_ZQ + (size_t)pm * 256 * 512, 512, WB + W_UQ + (size_t)pn * 256 * 512, 512, 512, lds3, EpiBf16<0>{ACT + A_Q + (size_t)pm * 256 * 1536 + pn * 256, 1536, 256});
      }
#pragma unroll 1
      for (int L = c; L < 130 * 8; L += G) {
        int pm, pn; tile_order(L, 130, 8, pm, pn); pm = opq(pm); pn = opq(pn);
        const size_t kr = kv_row(pm * 256);
        gemm_tile(ACT + A_ZKV + (size_t)pm * 256 * 256, 256, WB + W_UKV + (size_t)pn * 256 * 256, 256, 256, lds3, EpiKV{ACT + A_K + kr * 1536 + pn * 192, ACT + A_V + kr * 1024 + pn * 128});
      } }
    if (RUNPH(5)) { const P p = load_params<M_WS | (1u << 9) | (1u << 18)>(); phase_small(p, layer); }
    GSYNC();
    if (RUNPH(6)) { const P p = load_params<M_WS | (1u << 14) | (1u << 15)>(); phase_qk(p, layer); }
    GSYNC();
    DBG(2, A_K, (size_t)MT * 1536)
    if (DBG_STOP == 7 && layer == 0) { const bf16_t* a = (const bf16_t*)(load_params<M_WS>().ws + OFF_ACT); dbg_dump(a + A_ZPOOL, (size_t)MT * 512, a + A_U, (size_t)MT * 512); return; }
    if (RUNPH(7)) { const P p = load_params<M_WS>(); phase_attn(p, layer, smem); }
    GSYNC();
    DBG(3, A_ATT, (size_t)MT * 1024)
    if (RUNPH(8)) { const int G0 = ogrid(), c0 = obid();
#define MENV() ENV(); const int pm_ = opq(pm), pn_ = opq(pn); \
          unsigned char* s0 = p.ws + OFF_GS + (size_t)c * 131072; unsigned char* s1 = p.ws + OFF_YS + (size_t)c * 262144; unsigned char* s2 = s1 + 131072; \
          bf16_t* yp = ACT + A_Y + (size_t)pm_ * 256 * D + pn_ * 256; const bf16_t* gA = H + (size_t)pm_ * 256 * D; (void)yp; (void)gA; (void)s0; (void)s2;
#pragma unroll 1
      for (int L = c0; L < nMr * 8; L += G0) {
        int pm, pn; tile_order(L, nMr, 8, pm, pn);
        { MENV(); gemm_tile(gA, D, WB + W_G + (size_t)(0 * 2048 + pn_ * 256) * D, D, D, lds3, EpiGateR<0, false>{s0, s1, s2, 15}); }
        { MENV(); gemm_tile(gA, D, WB + W_G + (size_t)(1 * 2048 + pn_ * 256) * D, D, D, lds3, EpiGateR<1, false>{s0, s1, s2, 15}); }
        { MENV(); gemm_tile(gA, D, WB + W_G + (size_t)(2 * 2048 + pn_ * 256) * D, D, D, lds3, EpiGateR<2, false>{s0, s1, s2, 15}); }
        { Acc acc;
          { MENV(); gemm_tile_acc<true, false>(ACT + A_ZPOOL + (size_t)pm_ * 256 * 512, 512, WB + W_BP + (size_t)pn_ * 256 * 512, 512, 512, lds3, acc, EpiScale<false, false>{s0, yp, 15}); }
          { MENV(); gemm_tile_acc<false, false>(ACT + A_ATT + (size_t)pm_ * 256 * 1024, 1024, WB + W_BM + (size_t)pn_ * 256 * 1024, 1024, 1024, lds3, acc, EpiScale<false, false>{s1, yp, 15}); }
          { MENV(); gemm_tile_acc<false, false>(ACT + A_U + (size_t)pm_ * 256 * 512, 512, WB + W_BS + (size_t)pn_ * 256 * 512, 512, 512, lds3, acc, EpiScale<true, false>{s2, yp, 15}); } }
      }
#undef MENV
    }
    GSYNC();
    DBG(4, A_Y, (size_t)NLAT * D)
    if (RUNPH(9)) { ENV(); const int nFull = 128 * 8, nUnits = nFull + (layer == 0 ? 64 : 0);
#pragma unroll 1
      for (int L = c; L < nUnits; L += G) {
        int pm, pn, qmk = 15;
        if (L < nFull) tile_order(L, 128, 8, pm, pn); else { const int t = (L - nFull) >> 2; pm = 128 + (t >> 3); pn = t & 7; qmk = 1 << ((L - nFull) & 3); }
        pm = opq(pm); pn = opq(pn); qmk = opq(qmk);
        const int r0 = pm * 256; const float* gate = modl + mod_row(r0) * 12288 + 2 * 2048 + pn * 256;
        const float* xin = (r0 < NLAT ? xlat + (size_t)r0 * D : xctx + (size_t)(r0 - NLAT) * D) + pn * 256;
        float* xo = (r0 < NLAT ? p.out + (size_t)r0 * D : XC + (size_t)(r0 - NLAT) * D) + pn * 256;
        Acc acc;
        if (L < nFull) gemm_tile_acc<true, false>(ACT + A_Y + (size_t)r0 * D, D, WB + W_O + (size_t)pn * 256 * D, D, D, lds3, acc, EpiRes<false>{xin, xo, gate, 15});
        else gemm_tile_acc<true, true>(ACT + A_Y + (size_t)r0 * D, D, WB + W_O + (size_t)pn * 256 * D, D, D, lds3, acc, EpiRes<true>{xin, xo, gate, qmk}, qmk);
      } }
    GSYNC();
    if (DBG_STOP == 5 && layer == 0) return;
    if (RUNPH(1)) { ENV(); phase_norm(p.out, XC, p.norm2_g + layer * D, modl, 3, 4, H, true, layer == 0 ? MT : NLAT); }
    GSYNC();
    if (RUNPH(10)) { ENV(); const int nMf = layer == 0 ? 133 : 130;
#pragma unroll 1
      for (int L = c; L < nMf * 44; L += G) {
        int pm, pn; tile_order(L, nMf, 44, pm, pn); pm = opq(pm); pn = opq(pn);
        size_t hrow, frow; int nvalid, hole = 100000;
        if (pm < 130) { const int b = pm / 65, i = pm % 65; hrow = (size_t)b * HP_LAT + i * 254; frow = (size_t)b * SEQ + i * 254; nvalid = min(254, SEQ - i * 254); }
        else { const int i = pm - 130; hrow = (size_t)HP_CTX0 + i * 254; frow = (size_t)NLAT + i * 254; nvalid = i == 2 ? 6 : 254; hole = i == 0 ? 100000 : (i == 1 ? 3 : -2); }
        gemm_tile(H + hrow * D, D, WB + W_UP + (size_t)pn * 256 * D, D, D, lds3,
                  EpiConv{lds3, p.ffn_conv_w + (size_t)layer * 3 * F2, p.ffn_conv_b + (size_t)layer * F2, ACT + A_F + frow * DFF, pn * 128, nvalid, hole});
      } }
    GSYNC();
    DBG(6, A_F, (size_t)NLAT * D)
    if (RUNPH(11)) { ENV(); const int nFull = 128 * 8, nUnits = nFull + (layer == 0 ? 64 : 0);
#pragma unroll 1
      for (int L = c; L < nUnits; L += G) {
        int pm, pn, qmk = 15;
        if (L < nFull) tile_order(L, 128, 8, pm, pn); else { const int t = (L - nFull) >> 2; pm = 128 + (t >> 3); pn = t & 7; qmk = 1 << ((L - nFull) & 3); }
        pm = opq(pm); pn = opq(pn); qmk = opq(qmk);
        const int r0 = pm * 256; const float* gate = modl + mod_row(r0) * 12288 + 5 * 2048 + pn * 256;
        float* xo = (r0 < NLAT ? p.out + (size_t)r0 * D : XC + (size_t)(r0 - NLAT) * D) + pn * 256;
        Acc acc;
        if (L < nFull) gemm_tile_acc<true, false>(ACT + A_F + (size_t)r0 * DFF, DFF, WB + W_DN + (size_t)pn * 256 * DFF, DFF, DFF, lds3, acc, EpiRes<false>{xo, xo, gate, 15});
        else gemm_tile_acc<true, true>(ACT + A_F + (size_t)r0 * DFF, DFF, WB + W_DN + (size_t)pn * 256 * DFF, DFF, DFF, lds3, acc, EpiRes<true>{xo, xo, gate, qmk}, qmk);
      } }
    if (layer == 0) GSYNC();
  }
}

extern "C" void kernel_launch(void* const* d_in, const int* in_sizes, int n_in, void* d_out, int out_size, void* d_ws, size_t ws_size, hipStream_t stream) {
  static int grid_blocks = 0;
  if (grid_blocks == 0) {
    if (n_in != 28 || ws_size < WS_NEED) { fprintf(stderr, "kernel_launch: n_in %d ws %zu (need %zu)\n", n_in, ws_size, (size_t)WS_NEED); grid_blocks = -1; return; }
    int dev = 0, cus = 0, per_cu = 0;
    hipGetDevice(&dev);
    hipDeviceGetAttribute(&cus, hipDeviceAttributeMultiprocessorCount, dev);
    if (hipFuncSetAttribute((const void*)mega, hipFuncAttributeMaxDynamicSharedMemorySize, LDS_BYTES) != hipSuccess) { fprintf(stderr, "kernel_launch: LDS attribute failed\n"); grid_blocks = -1; return; }
    hipOccupancyMaxActiveBlocksPerMultiprocessor(&per_cu, (const void*)mega, NTHR, LDS_BYTES);
    if (per_cu < 1) { fprintf(stderr, "kernel_launch: occupancy query %d\n", per_cu); per_cu = 1; }
    (void)hipGetLastError();
    grid_blocks = cus;
    if (grid_blocks > 256) grid_blocks = 256;
  }
  if (grid_blocks < 0) return;
  hipMemsetAsync((char*)d_ws + OFF_CTL, 0, 4096, stream);
  P p{};
  const float** pp = (const float**)&p;
  for (int i = 0; i < 28; ++i) pp[i] = (const float*)d_in[i];
  p.out = (float*)d_out; p.ws = (unsigned char*)d_ws;
  void* args[] = {&p};
  hipError_t e = hipLaunchCooperativeKernel((const void*)mega, dim3(grid_blocks), dim3(NTHR), args, LDS_BYTES, stream);
  if (e != hipSuccess) fprintf(stderr, "cooperative launch failed: %s (grid %d)\n", hipGetErrorString(e), grid_blocks);
}
```
